# Optimizing an MI355X kernel written in HIP

```python
import jax, jax.numpy as jnp
from jax import lax
import numpy as np

D_MODEL = 1024
BATCH = 16
SEQ = 2048
DEPTH = 1

HGRN_HEADS = 8
HGRN_KEY_DIM = 128
HGRN_VAL_DIM = D_MODEL // HGRN_HEADS
HGRN_FWIDTH = HGRN_HEADS * HGRN_KEY_DIM
HGRN_WIDTH = HGRN_HEADS * HGRN_VAL_DIM
CHUNK = 16
POOL_WINDOWS = (2, 4, 8, 16)
POOL_GROUPS = len(POOL_WINDOWS)
POOL_WIDTH = D_MODEL
POOL_GROUP_DIM = POOL_WIDTH // POOL_GROUPS
D_FF = -(-(8 * D_MODEL) // (3 * 256)) * 256
RMS_EPS = 1e-6
IN_SPLITS = (HGRN_FWIDTH, HGRN_FWIDTH, HGRN_FWIDTH, HGRN_WIDTH, HGRN_WIDTH, POOL_WIDTH, D_MODEL, D_MODEL)
IN_WIDTH = sum(IN_SPLITS)

kernel_name = "hgrn2_multipool_gated_hybrid_encoder"


def rmsnorm(x, g):
    xf = x.astype(jnp.float32)
    y = xf * lax.rsqrt(jnp.mean(xf * xf, axis=-1, keepdims=True) + RMS_EPS)
    return (y * g.astype(jnp.float32)).astype(x.dtype)


def chunk_gated_recurrence(q, k, v, log_f):
    B, H, L, N = q.shape
    Dv = v.shape[-1]
    n_chunks = L // CHUNK

    def to_chunks(t):
        return jnp.moveaxis(t.reshape(B, H, n_chunks, CHUNK, t.shape[-1]), 2, 0)

    qc, kc, vc, gc = to_chunks(q), to_chunks(k), to_chunks(v), to_chunks(log_f)
    mask = jnp.tril(jnp.ones((CHUNK, CHUNK), dtype=bool))

    def step(S, inp):
        qi, ki, vi, gi = inp
        b = jnp.cumsum(gi, axis=-2)
        b_last = b[..., -1:, :]
        q_dec = qi * jnp.exp(b)
        k_inv = ki * jnp.exp(-b)
        scores = jnp.einsum('bhin,bhjn->bhij', q_dec, k_inv)
        scores = jnp.where(mask, scores, 0.0)
        o = (jnp.einsum('bhij,bhjd->bhid', scores, vi)
             + jnp.einsum('bhin,bhnd->bhid', q_dec, S))
        k_end = ki * jnp.exp(b_last - b)
        S = (jnp.exp(b_last)[..., 0, :, None] * S
             + jnp.einsum('bhjn,bhjd->bhnd', k_end, vi))
        return S, o

    S0 = jnp.zeros((B, H, N, Dv), q.dtype)
    _, o = lax.scan(step, S0, (qc, kc, vc, gc))
    return jnp.moveaxis(o, 0, 2).reshape(B, H, L, Dv)


def hgrn2_bidirectional(q_raw, ff_raw, fb_raw, i_raw, og_raw, lb, norm_g):
    B, L, _ = q_raw.shape
    f32 = jnp.float32

    def heads(t, d):
        return t.reshape(B, L, HGRN_HEADS, d).transpose(0, 2, 1, 3)

    q = heads(jax.nn.silu(q_raw.astype(f32)), HGRN_KEY_DIM)
    v = heads(i_raw.astype(f32), HGRN_VAL_DIM)
    f_fwd = lb[0] + (1.0 - lb[0]) * jax.nn.sigmoid(ff_raw.astype(f32))
    f_bwd = lb[1] + (1.0 - lb[1]) * jax.nn.sigmoid(fb_raw.astype(f32))
    f = jnp.concatenate([heads(f_fwd, HGRN_KEY_DIM), heads(f_bwd, HGRN_KEY_DIM)[:, :, ::-1]], axis=1)
    qq = jnp.concatenate([q, q[:, :, ::-1]], axis=1)
    vv = jnp.concatenate([v, v[:, :, ::-1]], axis=1)
    o = chunk_gated_recurrence(qq, 1.0 - f, vv, jnp.log(f))
    o = o[:, :HGRN_HEADS] + o[:, HGRN_HEADS:, ::-1]
    o = o * lax.rsqrt(jnp.mean(o * o, axis=-1, keepdims=True) + RMS_EPS)
    o = o.transpose(0, 2, 1, 3).reshape(B, L, HGRN_WIDTH) * norm_g.astype(f32)
    return (o * jax.nn.silu(og_raw.astype(f32))).astype(q_raw.dtype)


def multiscale_pool(p, w_grp, scale):
    B, L, _ = p.shape
    f32 = jnp.float32
    pg = p.astype(f32).reshape(B, L, POOL_GROUPS, POOL_GROUP_DIM)
    cs = jnp.concatenate([jnp.zeros((B, 1, POOL_GROUPS, POOL_GROUP_DIM), f32),
                          jnp.cumsum(pg, axis=1)], axis=1)
    half = jnp.array([w // 2 for w in POOL_WINDOWS], dtype=jnp.int32)
    t = jnp.arange(L, dtype=jnp.int32)[:, None]
    lo = jnp.clip(t - half + 1, 0, L)
    hi = jnp.clip(t + half + 1, 0, L)
    gidx = jnp.arange(POOL_GROUPS, dtype=jnp.int32)[None, :]
    win_sum = cs[:, hi, gidx, :] - cs[:, lo, gidx, :]
    count = (hi - lo).astype(f32)[..., None]
    y = win_sum / count - pg
    y = jnp.einsum('blgc,gcd->blgd', y, w_grp.astype(f32))
    return (y.reshape(B, L, POOL_WIDTH) * scale.astype(f32)).astype(p.dtype)


def setup_inputs(seed: int = 0) -> dict:
    key = jax.random.key(seed)
    ks = jax.random.split(key, 16)
    f32 = jnp.float32
    nrm = lambda k, shape, fan_in: jax.random.normal(k, shape, f32) * (fan_in ** -0.5)
    gain = lambda k, shape: 1.0 + 0.02 * jax.random.normal(k, shape, f32)
    return {
        "x": jax.random.normal(ks[0], (BATCH, SEQ, D_MODEL), f32),
        "g_mix": gain(ks[1], (DEPTH, D_MODEL)),
        "w_in": nrm(ks[2], (DEPTH, D_MODEL, IN_WIDTH), D_MODEL),
        "lb_logits": 0.1 * jax.random.normal(ks[3], (2, DEPTH + 1, HGRN_FWIDTH), f32),
        "hgrn_norm_g": gain(ks[4], (DEPTH, HGRN_WIDTH)),
        "pool_w": nrm(ks[5], (DEPTH, POOL_GROUPS, POOL_GROUP_DIM, POOL_GROUP_DIM), POOL_GROUP_DIM),
        "pool_scale": gain(ks[6], (DEPTH, POOL_WIDTH)),
        "w_branch_a": nrm(ks[7], (DEPTH, HGRN_WIDTH, D_MODEL), HGRN_WIDTH),
        "w_branch_b": nrm(ks[8], (DEPTH, POOL_WIDTH, D_MODEL), POOL_WIDTH),
        "w_out": nrm(ks[9], (DEPTH, D_MODEL, D_MODEL), D_MODEL),
        "g_ffn": gain(ks[10], (DEPTH, D_MODEL)),
        "w_ffn_in": nrm(ks[11], (DEPTH, D_MODEL, 2 * D_FF), D_MODEL),
        "w_ffn_out": nrm(ks[12], (DEPTH, D_FF, D_MODEL), D_FF),
        "g_final": gain(ks[13], (D_MODEL,)),
    }


def reference(x, g_mix, w_in, lb_logits, hgrn_norm_g, pool_w, pool_scale, w_branch_a,
              w_branch_b, w_out, g_ffn, w_ffn_in, w_ffn_out, g_final):
    lb_all = jnp.cumsum(jax.nn.softmax(lb_logits.astype(jnp.float32), axis=1), axis=1)
    offsets = np.cumsum(IN_SPLITS)[:-1].tolist()
    h = x
    for l in range(DEPTH):
        u = rmsnorm(h, g_mix[l])
        proj = jnp.einsum('bsd,de->bse', u, w_in[l])
        q_r, ff_r, fb_r, i_r, og_r, p_r, ga_r, gb_r = jnp.split(proj, offsets, axis=-1)
        y_a = hgrn2_bidirectional(q_r, ff_r, fb_r, i_r, og_r, lb_all[:, l], hgrn_norm_g[l])
        y_b = multiscale_pool(p_r, pool_w[l], pool_scale[l])
        z_a = jnp.einsum('bse,ed->bsd', y_a, w_branch_a[l])
        z_b = jnp.einsum('bse,ed->bsd', y_b, w_branch_b[l])
        merged = jax.nn.sigmoid(ga_r) * z_a + jax.nn.sigmoid(gb_r) * z_b
        h = h + jnp.einsum('bsd,de->bse', merged, w_out[l])
        u = rmsnorm(h, g_ffn[l])
        gate, up = jnp.split(jnp.einsum('bsd,df->bsf', u, w_ffn_in[l]), 2, axis=-1)
        h = h + jnp.einsum('bsf,fd->bsd', jax.nn.silu(gate) * up, w_ffn_out[l])
    return rmsnorm(h, g_final)
```

```cpp
#include <hip/hip_runtime.h>
#include <hip/hip_cooperative_groups.h>
#include <cstdio>
#include <cstdint>
namespace cg = cooperative_groups;

#define LAS __attribute__((address_space(3)))
#define DI __device__ __forceinline__
typedef unsigned short bf16_t;
typedef short bf16x8 __attribute__((ext_vector_type(8)));
typedef short bf16x4 __attribute__((ext_vector_type(4)));
typedef float f32x4 __attribute__((ext_vector_type(4)));
typedef float f32x2 __attribute__((ext_vector_type(2)));
typedef unsigned u32x4 __attribute__((ext_vector_type(4)));
typedef unsigned u32x2 __attribute__((ext_vector_type(2)));

constexpr int MTOK = 32768, DM = 1024, SEQ = 2048, NB = 16, NH = 8, FF = 2816;
constexpr float EPS = 1e-6f;
constexpr size_t MiB = (size_t)1 << 20;
constexpr size_t OFF_WIN = 0;
constexpr size_t OFF_WAB = 16 * MiB;
constexpr size_t OFF_WO = 20 * MiB;
constexpr size_t OFF_WFI = 22 * MiB;
constexpr size_t OFF_WFO = 33 * MiB;
constexpr size_t OFF_SSQ2 = 39 * MiB;
constexpr size_t OFF_SSQ3 = OFF_SSQ2 + 131072;
constexpr size_t OFF_OML = OFF_SSQ3 + 131072;
constexpr size_t OFF_BAR = 40 * MiB;
constexpr size_t OFF_XB = 41 * MiB;
constexpr size_t OFF_S0 = 105 * MiB;
constexpr size_t SPL = 64 * MiB;
constexpr size_t OFF_S1 = OFF_S0 + SPL;
constexpr size_t OFF_S2 = OFF_S1 + SPL;
constexpr size_t OFF_S3 = OFF_S2 + SPL;
constexpr size_t OFF_S4 = OFF_S3 + SPL;
constexpr size_t OFF_S5 = OFF_S4 + SPL;
constexpr size_t OFF_ACT = OFF_XB;
constexpr size_t WS_END = OFF_S5 + SPL;
constexpr int LDS_BYTES = 163840;

struct Params {
    const float *x, *g_mix, *w_in, *lb_logits, *hgrn_g, *pool_w, *pool_scale, *w_a, *w_b, *w_out, *g_ffn, *w_fi, *w_fo, *g_final;
    float* out; unsigned char* ws;
};

DI unsigned pk2(float lo, float hi) {
    typedef __bf16 bf2 __attribute__((ext_vector_type(2)));
    f32x2 v = {lo, hi};
    bf2 b = __builtin_convertvector(v, bf2);
    return __builtin_bit_cast(unsigned, b);
}
DI float bf_lo(unsigned u) { return __uint_as_float(u << 16); }
DI float bf_hi(unsigned u) { return __uint_as_float(u & 0xffff0000u); }
DI float bf2f(bf16_t h) { return __uint_as_float(((unsigned)h) << 16); }
DI float fast_rcp(float x) { return __builtin_amdgcn_rcpf(x); }
DI float sigmoidf_(float v) { return fast_rcp(1.0f + __expf(-v)); }
DI float siluf_(float v) { return v * fast_rcp(1.0f + __expf(-v)); }
DI float wave_sum(float v) {
#pragma unroll
    for (int o = 1; o < 64; o <<= 1) v += __shfl_xor(v, o);
    return v;
}
#define LDS_WAIT() asm volatile("s_waitcnt lgkmcnt(0)" ::: "memory")

namespace pg8 {
constexpr int BM = 256, BK = 64, HALF = 128, HTB = HALF * BK * 2, STAGE_BYTES = 8 * HTB, NXCD = 8;
DI int lds_byte(int r, int c) { const int st = (r >> 4) * 2 + (c >> 5), rr = r & 15, cc = c & 31, ob = rr * 64 + cc * 2; return st * 1024 + (ob ^ (((ob >> 9) & 1) << 5)); }
DI void stage_rc(int b, int& R, int& C) { const int st = b / 1024, sb = b % 1024, swz = sb ^ (((sb >> 9) & 1) << 5); R = (st >> 1) * 16 + swz / 64; C = (st & 1) * 32 + (swz % 64) / 2; }
DI int perm32(int rho) { const int n = rho >> 4, i = rho & 15; return 8 * (i >> 2) + 4 * n + (i & 3); }

struct Unit { int pm, pn; };
struct Gemm { const bf16_t* A; const bf16_t* A2; const bf16_t* Bt; int K; int nsplit; };

struct StaticOrder {
    int nM, nN, nwg, G, c, WGM;
    DI void init(int M, int N, int G_, int c_, int wgm = 4) { nM = M / BM; nN = N / BM; nwg = nM * nN; G = G_; c = c_; WGM = wgm; }
    DI bool next(int i, Unit& u) const {
        const long L = (long)i * G + c; if (L >= nwg) return false;
        int wgid = (int)L; { const int q = nwg / NXCD, r = nwg % NXCD, xcd = wgid % NXCD, off = wgid / NXCD; wgid = (xcd < r ? xcd * (q + 1) : r * (q + 1) + (xcd - r) * q) + off; }
        const int nig = WGM * nN, gid = wgid / nig, fm = gid * WGM, gsz = (nM - fm) < WGM ? (nM - fm) : WGM;
        u.pm = fm + ((wgid % nig) % gsz); u.pn = (wgid % nig) / gsz; return true;
    }
};
struct PairOrder {
    StaticOrder so;
    DI bool next(int i, Unit& u) const { Unit t; if (!so.next(i >> 1, t)) return false; u.pm = t.pm; u.pn = t.pn + 4 * (i & 1); return true; }
};

template <class Epi, class Sched>
DI void gemm_phase(LAS unsigned char* lds, const Gemm g, const Sched& S, const Epi& E) {
    const int tid = threadIdx.x, wid = __builtin_amdgcn_readfirstlane(tid >> 6), lane = tid & 63, wr = wid >> 2, wc = wid & 3, fr = lane & 15, fq = lane >> 4;
    const int K = g.K, nt = K / BK;
    unsigned voffA[2], voffB[2];
#pragma unroll
    for (int i = 0; i < 2; ++i) { int R, C; stage_rc(tid * 16 + i * 8192, R, C); const int Rb = ((R & ~31) + perm32(R & 31));
        voffA[i] = (unsigned)(R * K + C) * 2u; voffB[i] = (unsigned)(Rb * K + C) * 2u; }
    const size_t kstep = (size_t)(BK * 2);
    const size_t hstep = (size_t)HALF * K * 2;
    const size_t tstep = 2 * hstep;
    const unsigned ldsw = (unsigned)wid * 1024u;
    const int aoff = lds_byte(wr * 64 + fr, fq * 8), boff = lds_byte(wc * 32 + fr, fq * 8);
#define PG8_SA(b, h) (((b) * 2 + (h)) * HTB)
#define PG8_SB(b, h) ((4 + (b) * 2 + (h)) * HTB)
#define PG8_STAGE(bufoff, gbase, voff) do { _Pragma("unroll") for (int _i = 0; _i < 2; ++_i) \
        __builtin_amdgcn_global_load_lds((const unsigned*)((const char*)(gbase) + (voff)[_i]), (LAS unsigned*)(lds + (bufoff) + ldsw + _i * 8192), 16, 0, 0); } while (0)
#define PG8_LDA(dst, b, h) do { _Pragma("unroll") for (int m = 0; m < 4; ++m) _Pragma("unroll") for (int k = 0; k < 2; ++k) dst[m][k] = *(const LAS bf16x8*)(lds + PG8_SA(b, h) + aoff + m * 2048 + k * 1024); } while (0)
#define PG8_LDB(dst, b, h) do { _Pragma("unroll") for (int n = 0; n < 2; ++n) _Pragma("unroll") for (int k = 0; k < 2; ++k) dst[n][k] = *(const LAS bf16x8*)(lds + PG8_SB(b, h) + boff + n * 2048 + k * 1024); } while (0)
#define PG8_MMA(ai, bj, At, Bt) do { __builtin_amdgcn_s_setprio(1); _Pragma("unroll") for (int m = 0; m < 4; ++m) _Pragma("unroll") for (int n = 0; n < 2; ++n) _Pragma("unroll") for (int k = 0; k < 2; ++k) \
        acc[ai][bj][m][n] = __builtin_amdgcn_mfma_f32_16x16x32_bf16(Bt[n][k], At[m][k], acc[ai][bj][m][n], 0, 0, 0); __builtin_amdgcn_s_setprio(0); } while (0)
#define PG8_WAIT_V(n) asm volatile("s_waitcnt vmcnt(" #n ")" ::: "memory")
#define PG8_WAIT_L(n) asm volatile("s_waitcnt lgkmcnt(" #n ")" ::: "memory")
#define PG8_BAR __builtin_amdgcn_s_barrier()
#define PG8_SCHED __builtin_amdgcn_sched_barrier(0)
#define PG8_ABASE(u) ((const char*)((u).pn >= g.nsplit ? g.A2 : g.A) + (size_t)(u).pm * tstep)
    Unit cur, nxt; int ui = 0;
    if (!S.next(0, cur)) return;
    f32x4 acc[2][2][4][2];
#pragma unroll
    for (int a = 0; a < 2; ++a)
#pragma unroll
        for (int b = 0; b < 2; ++b)
#pragma unroll
            for (int m = 0; m < 4; ++m)
#pragma unroll
                for (int n = 0; n < 2; ++n) acc[a][b][m][n] = (f32x4){0.f, 0.f, 0.f, 0.f};
    bf16x8 At[4][2], B0[2][2], B1[2][2];
    const char* cA = PG8_ABASE(cur); const char* cB = (const char*)g.Bt + (size_t)cur.pn * tstep;
    PG8_STAGE(PG8_SB(0, 0), cB, voffB); PG8_STAGE(PG8_SB(0, 1), cB + hstep, voffB); PG8_STAGE(PG8_SA(0, 0), cA, voffA); PG8_STAGE(PG8_SA(0, 1), cA + hstep, voffA);
    if (wr == 1) PG8_BAR;
    PG8_WAIT_V(2); PG8_BAR;
    PG8_STAGE(PG8_SB(1, 0), cB + kstep, voffB); PG8_STAGE(PG8_SA(1, 0), cA + kstep, voffA); PG8_STAGE(PG8_SB(1, 1), cB + hstep + kstep, voffB);
    PG8_WAIT_V(6); PG8_BAR;
    for (;;) {
        const bool has_next = S.next(ui + 1, nxt);
        const char* nA = has_next ? PG8_ABASE(nxt) : cA; const char* nB = has_next ? (const char*)g.Bt + (size_t)nxt.pn * tstep : cB;
        for (int t = 0; t < nt; t += 2) {
            const bool last = (t == nt - 2);
            const char* a1 = cA + (size_t)(t + 1) * kstep;
            const char* a2 = last ? nA : cA + (size_t)(t + 2) * kstep; const char* b2 = last ? nB : cB + (size_t)(t + 2) * kstep;
            const char* a3 = a2 + kstep; const char* b3 = b2 + kstep;
            PG8_LDB(B0, 0, 0); PG8_LDB(B1, 0, 1); PG8_SCHED; PG8_LDA(At, 0, 0); PG8_STAGE(PG8_SA(1, 1), a1 + hstep, voffA);
            PG8_WAIT_V(8); PG8_WAIT_L(0); PG8_BAR; PG8_MMA(0, 0, At, B0); PG8_MMA(0, 1, At, B1); PG8_BAR; PG8_SCHED;
            PG8_LDA(At, 0, 1); PG8_STAGE(PG8_SB(0, 0), b2, voffB); PG8_STAGE(PG8_SB(0, 1), b2 + hstep, voffB); PG8_STAGE(PG8_SA(0, 0), a2, voffA);
            PG8_WAIT_V(8); PG8_WAIT_L(0); PG8_BAR; PG8_MMA(1, 0, At, B0); PG8_MMA(1, 1, At, B1); PG8_BAR; PG8_SCHED;
            PG8_LDB(B0, 1, 0); PG8_LDB(B1, 1, 1); PG8_SCHED; PG8_LDA(At, 1, 0); PG8_STAGE(PG8_SA(0, 1), a2 + hstep, voffA);
            PG8_WAIT_V(8); PG8_WAIT_L(0); PG8_BAR; PG8_MMA(0, 0, At, B0); PG8_MMA(0, 1, At, B1); PG8_BAR; PG8_SCHED;
            PG8_LDA(At, 1, 1); PG8_STAGE(PG8_SB(1, 0), b3, voffB); PG8_STAGE(PG8_SB(1, 1), b3 + hstep, voffB); PG8_STAGE(PG8_SA(1, 0), a3, voffA);
            PG8_WAIT_V(8); PG8_WAIT_L(0); PG8_BAR; PG8_MMA(1, 0, At, B0); PG8_MMA(1, 1, At, B1); PG8_BAR; PG8_SCHED;
        }
        if (wr == 0) PG8_BAR;
        const bool keep = E(acc, cur, wr, wc, fr, fq);
        if (!has_next) break;
        if (!keep) {
#pragma unroll
        for (int a = 0; a < 2; ++a)
#pragma unroll
            for (int b = 0; b < 2; ++b)
#pragma unroll
                for (int m = 0; m < 4; ++m)
#pragma unroll
                    for (int n = 0; n < 2; ++n) acc[a][b][m][n] = (f32x4){0.f, 0.f, 0.f, 0.f};
        }
        cur = nxt; cA = nA; cB = nB; ++ui;
        if (wr == 1) PG8_BAR;
    }
    PG8_WAIT_V(0);
    PG8_BAR;
#undef PG8_SA
#undef PG8_SB
#undef PG8_STAGE
#undef PG8_LDA
#undef PG8_LDB
#undef PG8_MMA
#undef PG8_WAIT_V
#undef PG8_WAIT_L
#undef PG8_BAR
#undef PG8_SCHED
#undef PG8_ABASE
}

typedef f32x4 Acc[2][2][4][2];

struct EpiProj {
    unsigned char* ws; float* dout; const float* oml;
    template <int MODE> DI void run(const Acc& acc, bf16_t* base, const float* omlp, int row0, int col0) const {
        f32x4 ov[2][2];
#pragma unroll
        for (int bj = 0; bj < 2; ++bj)
#pragma unroll
            for (int n = 0; n < 2; ++n) ov[bj][n] = (MODE == 3) ? *(const f32x4*)(omlp + col0 + bj * HALF + 4 * n) : (f32x4){0.f, 0.f, 0.f, 0.f};
#pragma unroll
        for (int ai = 0; ai < 2; ++ai)
#pragma unroll
            for (int m = 0; m < 4; ++m) { bf16_t* rowp = base + (size_t)(row0 + ai * HALF + m * 16) * DM + col0;
#pragma unroll
                for (int bj = 0; bj < 2; ++bj) { f32x4 v[2] = {acc[ai][bj][m][0], acc[ai][bj][m][1]};
#pragma unroll
                    for (int n = 0; n < 2; ++n)
#pragma unroll
                        for (int j = 0; j < 4; ++j) { const float t = v[n][j];
                            if (MODE == 1) v[n][j] = siluf_(t);
                            if (MODE == 2) v[n][j] = sigmoidf_(t);
                            if (MODE == 3) v[n][j] = ov[bj][n][j] * fast_rcp(1.0f + __expf(t)); }
                    u32x4 w; w.x = pk2(v[0][0], v[0][1]); w.y = pk2(v[0][2], v[0][3]); w.z = pk2(v[1][0], v[1][1]); w.w = pk2(v[1][2], v[1][3]);
                    *(u32x4*)(rowp + bj * HALF) = w; } }
    }
    DI bool operator()(Acc& acc, const Unit& u, int wr, int wc, int fr, int fq) const {
        const int split = u.pn >> 2, colt = (u.pn & 3) * BM;
        bf16_t* base = split < 6 ? (bf16_t*)(ws + OFF_S0 + (size_t)split * SPL) : (bf16_t*)((unsigned char*)dout + (size_t)(split - 6) * SPL);
        const int row0 = u.pm * BM + wr * 64 + fr, col0 = colt + wc * 32 + 8 * fq;
        if (split == 0) run<1>(acc, base, oml, row0, col0);
        else if (split == 1) run<3>(acc, base, oml, row0, col0);
        else if (split == 2) run<3>(acc, base, oml + DM, row0, col0);
        else if (split == 3 || split == 4 || split == 5) run<0>(acc, base, oml, row0, col0);
        else run<2>(acc, base, oml, row0, col0);
        return false;
    }
};

struct EpiMerge {
    const bf16_t* gates;
    bf16_t* merged;
    DI bool operator()(Acc& acc, const Unit& u, int wr, int wc, int fr, int fq) const {
        const int sel = u.pn >> 2, colt = (u.pn & 3) * BM;
        const bf16_t* ga = gates; const bf16_t* gb = gates + (size_t)MTOK * DM;
        const int row0 = u.pm * BM + wr * 64 + fr, col0 = colt + wc * 32 + 8 * fq;
#pragma unroll
        for (int ai = 0; ai < 2; ++ai) {
            u32x4 bw[4][2], aw[4][2];
#pragma unroll
            for (int m = 0; m < 4; ++m)
#pragma unroll
                for (int bj = 0; bj < 2; ++bj) { const size_t off = (size_t)(row0 + ai * HALF + m * 16) * DM + col0 + bj * HALF;
                    bw[m][bj] = *(const u32x4*)(gb + off); aw[m][bj] = (sel == 0) ? *(const u32x4*)(ga + off) : (u32x4){0u, 0u, 0u, 0u}; }
            asm volatile("" ::: "memory");
#pragma unroll
            for (int m = 0; m < 4; ++m)
#pragma unroll
                for (int bj = 0; bj < 2; ++bj) { const size_t off = (size_t)(row0 + ai * HALF + m * 16) * DM + col0 + bj * HALF;
                    const u32x4 b4 = bw[m][bj];
                    float sb[8] = {bf_lo(b4.x), bf_hi(b4.x), bf_lo(b4.y), bf_hi(b4.y), bf_lo(b4.z), bf_hi(b4.z), bf_lo(b4.w), bf_hi(b4.w)};
#pragma unroll
                    for (int j = 0; j < 8; ++j) sb[j] = fmaxf(sb[j], 1e-20f);
                    if (sel == 0) {
                        const u32x4 a4 = aw[m][bj];
                        const float sa[8] = {bf_lo(a4.x), bf_hi(a4.x), bf_lo(a4.y), bf_hi(a4.y), bf_lo(a4.z), bf_hi(a4.z), bf_lo(a4.w), bf_hi(a4.w)};
#pragma unroll
                        for (int j = 0; j < 4; ++j) { acc[ai][bj][m][0][j] *= sa[j] * fast_rcp(sb[j]); acc[ai][bj][m][1][j] *= sa[4 + j] * fast_rcp(sb[4 + j]); }
                    } else {
                        const f32x4 v0 = acc[ai][bj][m][0], v1 = acc[ai][bj][m][1];
                        u32x4 w; w.x = pk2(v0[0] * sb[0], v0[1] * sb[1]); w.y = pk2(v0[2] * sb[2], v0[3] * sb[3]); w.z = pk2(v1[0] * sb[4], v1[1] * sb[5]); w.w = pk2(v1[2] * sb[6], v1[3] * sb[7]);
                        *(u32x4*)(merged + off) = w; } }
        }
        return sel == 0;
    }
};

template <bool WITH_BF16, bool WRITE_F32, bool BASE_BF16> struct EpiResid {
    const void* base; float* outf; bf16_t* outb; float* ssq;
    DI bool operator()(Acc& acc, const Unit& u, int wr, int wc, int fr, int fq) const {
        const int row0 = u.pm * BM + wr * 64 + fr, col0 = u.pn * BM + wc * 32 + 8 * fq;
#pragma unroll
        for (int ai = 0; ai < 2; ++ai) {
            f32x4 bq[4][2][2];
#pragma unroll
            for (int m = 0; m < 4; ++m)
#pragma unroll
                for (int bj = 0; bj < 2; ++bj) { const size_t off = (size_t)(row0 + ai * HALF + m * 16) * DM + col0 + bj * HALF;
                    if (BASE_BF16) { const u32x4 bw = *(const u32x4*)((const bf16_t*)base + off);
                        bq[m][bj][0] = (f32x4){__uint_as_float(bw.x), __uint_as_float(bw.y), __uint_as_float(bw.z), __uint_as_float(bw.w)}; bq[m][bj][1] = bq[m][bj][0]; }
                    else { bq[m][bj][0] = *(const f32x4*)((const float*)base + off); bq[m][bj][1] = *(const f32x4*)((const float*)base + off + 4); } }
            asm volatile("" ::: "memory");
#pragma unroll
            for (int m = 0; m < 4; ++m) { const int row = row0 + ai * HALF + m * 16; float s = 0.f;
#pragma unroll
                for (int bj = 0; bj < 2; ++bj) { const size_t off = (size_t)row * DM + col0 + bj * HALF;
                    f32x4 b0, b1;
                    if (BASE_BF16) { const unsigned wx = __float_as_uint(bq[m][bj][0][0]), wy = __float_as_uint(bq[m][bj][0][1]), wz = __float_as_uint(bq[m][bj][0][2]), ww = __float_as_uint(bq[m][bj][0][3]);
                        b0 = (f32x4){bf_lo(wx), bf_hi(wx), bf_lo(wy), bf_hi(wy)}; b1 = (f32x4){bf_lo(wz), bf_hi(wz), bf_lo(ww), bf_hi(ww)}; }
                    else { b0 = bq[m][bj][0]; b1 = bq[m][bj][1]; }
                    const f32x4 v0 = acc[ai][bj][m][0] + b0, v1 = acc[ai][bj][m][1] + b1;
                    if (WRITE_F32) { *(f32x4*)(outf + off) = v0; *(f32x4*)(outf + off + 4) = v1; }
                    s += (v0[0] * v0[0] + v0[1] * v0[1]) + (v0[2] * v0[2] + v0[3] * v0[3]) + (v1[0] * v1[0] + v1[1] * v1[1]) + (v1[2] * v1[2] + v1[3] * v1[3]);
                    if (WITH_BF16) { u32x4 w; w.x = pk2(v0[0], v0[1]); w.y = pk2(v0[2], v0[3]); w.z = pk2(v1[0], v1[1]); w.w = pk2(v1[2], v1[3]);
                        *(u32x4*)(outb + off) = w; } }
                s += __shfl_xor(s, 16); s += __shfl_xor(s, 32);
                if (fq == 0) atomicAdd(ssq + row, s); }
        }
        return false;
    }
};

struct EpiSwiglu {
    const float* ssq; bf16_t* act;
    DI bool operator()(Acc& acc, const Unit& u, int wr, int wc, int fr, int fq) const {
        const int row0 = u.pm * BM + wr * 64 + fr, col0 = u.pn * HALF + wc * 32 + 8 * fq;
#pragma unroll
        for (int ai = 0; ai < 2; ++ai)
#pragma unroll
            for (int m = 0; m < 4; ++m) { const int row = row0 + ai * HALF + m * 16;
                const float r = rsqrtf(ssq[row] * (1.0f / DM) + EPS);
                float o[8];
#pragma unroll
                for (int n = 0; n < 2; ++n)
#pragma unroll
                    for (int j = 0; j < 4; ++j) { const float gt = acc[ai][0][m][n][j] * r, up = acc[ai][1][m][n][j] * r; o[4 * n + j] = siluf_(gt) * up; }
                u32x4 w; w.x = pk2(o[0], o[1]); w.y = pk2(o[2], o[3]); w.z = pk2(o[4], o[5]); w.w = pk2(o[6], o[7]);
                *(u32x4*)(act + (size_t)row * FF + col0) = w; }
        return false;
    }
};
}

DI void tr_item(const float* W, int N, bf16_t* WT, int K, int k0, int n0, int drow0, const float* ksc, LAS float* scr, int lane) {
    float v[64];
#pragma unroll
    for (int i = 0; i < 64; ++i) v[i] = W[(size_t)(k0 + i) * N + n0 + lane];
    if (ksc) {
#pragma unroll
        for (int i = 0; i < 64; ++i) v[i] *= ksc[k0 + i];
    }
#pragma unroll
    for (int i = 0; i < 64; ++i) scr[i * 65 + lane] = v[i];
    LDS_WAIT();
    const int c = lane & 7;
#pragma unroll
    for (int j = 0; j < 8; ++j) { const int n = (lane >> 3) + 8 * j; const LAS float* s = scr + (8 * c) * 65 + n;
        u32x4 o; o.x = pk2(s[0 * 65], s[1 * 65]); o.y = pk2(s[2 * 65], s[3 * 65]); o.z = pk2(s[4 * 65], s[5 * 65]); o.w = pk2(s[6 * 65], s[7 * 65]);
        *(u32x4*)(WT + (size_t)(drow0 + n) * K + k0 + 8 * c) = o; }
    LDS_WAIT();
}

DI void phase0(const Params& p, LAS unsigned char* lds) {
    const int tid = threadIdx.x, lane = tid & 63, wave = tid >> 6, G = gridDim.x;
    unsigned char* ws = p.ws;
    {
        LAS float* As = (LAS float*)lds;
        LAS float* Bs = (LAS float*)(lds + 32768);
        bf16_t* dst = (bf16_t*)(ws + OFF_WAB) + (size_t)DM * DM;
        for (int T = blockIdx.x; T < 256; T += G) {
            const int d0 = (T >> 4) * 64, rt = T & 15, g = rt >> 2, c0 = (rt & 3) * 64;
            const int cc = tid & 63, dq = tid >> 6;
            float acc[8];
#pragma unroll
            for (int j = 0; j < 8; ++j) acc[j] = 0.f;
            for (int eh = 0; eh < 256; eh += 128) {
                __syncthreads();
                for (int idx = tid; idx < 128 * 16; idx += 512) { const int e = idx >> 4, d4 = idx & 15; const int er = 256 * g + eh + e;
                    f32x4 v = *(const f32x4*)(p.w_b + (size_t)er * DM + d0 + 4 * d4); const float s = p.pool_scale[er];
                    *(LAS f32x4*)(As + e * 64 + 4 * d4) = v * s; }
                for (int idx = tid; idx < 64 * 32; idx += 512) { const int c = idx >> 5, e4 = idx & 31;
                    const f32x4 v = *(const f32x4*)(p.pool_w + ((size_t)(g * 256 + c0 + c)) * 256 + eh + 4 * e4);
                    LAS float* b = Bs + c * 129 + 4 * e4; b[0] = v[0]; b[1] = v[1]; b[2] = v[2]; b[3] = v[3]; }
                __syncthreads();
#pragma unroll 4
                for (int e = 0; e < 128; ++e) { const float b = Bs[cc * 129 + e];
                    const f32x4 a0 = *(const LAS f32x4*)(As + e * 64 + dq * 8), a1 = *(const LAS f32x4*)(As + e * 64 + dq * 8 + 4);
                    acc[0] += a0[0] * b; acc[1] += a0[1] * b; acc[2] += a0[2] * b; acc[3] += a0[3] * b;
                    acc[4] += a1[0] * b; acc[5] += a1[1] * b; acc[6] += a1[2] * b; acc[7] += a1[3] * b; }
            }
#pragma unroll
            for (int j = 0; j < 8; ++j) dst[(size_t)(d0 + dq * 8 + j) * DM + 256 * g + c0 + cc] = (bf16_t)(pk2(acc[j], 0.f) & 0xffffu);
        }
        __syncthreads();
    }
    {
        LAS float* scr = (LAS float*)(lds + wave * 16640);
        const int gw = blockIdx.x * 8 + wave, NGW = G * 8;
        constexpr int I_IN = 16 * 128, I_A = 16 * 16, I_O = 16 * 16, I_FI = 16 * 88, I_FO = 44 * 16;
        constexpr int NITEMS = I_IN + I_A + I_O + I_FI + I_FO;
        for (int it = gw; it < NITEMS; it += NGW) {
            int r = it;
            if (r < I_IN) { const int kb = r / 128, nb = r % 128; tr_item(p.w_in, 8192, (bf16_t*)(ws + OFF_WIN), DM, 64 * kb, 64 * nb, 64 * nb, nullptr, scr, lane); continue; } r -= I_IN;
            if (r < I_A) { const int kb = r / 16, nb = r % 16; tr_item(p.w_a, DM, (bf16_t*)(ws + OFF_WAB), DM, 64 * kb, 64 * nb, 64 * nb, nullptr, scr, lane); continue; } r -= I_A;
            if (r < I_O) { const int kb = r / 16, nb = r % 16; tr_item(p.w_out, DM, (bf16_t*)(ws + OFF_WO), DM, 64 * kb, 64 * nb, 64 * nb, nullptr, scr, lane); continue; } r -= I_O;
            if (r < I_FI) { const int kb = r / 88, nb = r % 88; const int n0 = 64 * nb; const int nn = n0 < FF ? n0 : n0 - FF;
                const int drow0 = 256 * (nn >> 7) + (n0 < FF ? 0 : 128) + (nn & 127);
                tr_item(p.w_fi, 2 * FF, (bf16_t*)(ws + OFF_WFI), DM, 64 * kb, n0, drow0, p.g_ffn, scr, lane); continue; } r -= I_FI;
            { const int kb = r / 16, nb = r % 16; tr_item(p.w_fo, DM, (bf16_t*)(ws + OFF_WFO), FF, 64 * kb, 64 * nb, 64 * nb, nullptr, scr, lane); }
        }
        bf16_t* xb = (bf16_t*)(ws + OFF_XB);
        for (int rb = gw * 4; rb < MTOK; rb += NGW * 4) {
            f32x4 v[4][4]; float sq[4];
#pragma unroll
            for (int r = 0; r < 4; ++r) { const f32x4* xr = (const f32x4*)(p.x + (size_t)(rb + r) * DM) + lane;
#pragma unroll
                for (int j = 0; j < 4; ++j) v[r][j] = xr[64 * j]; }
#pragma unroll
            for (int r = 0; r < 4; ++r) { float s = 0.f;
#pragma unroll
                for (int j = 0; j < 4; ++j) s += (v[r][j][0] * v[r][j][0] + v[r][j][1] * v[r][j][1]) + (v[r][j][2] * v[r][j][2] + v[r][j][3] * v[r][j][3]);
                sq[r] = s; }
#pragma unroll
            for (int o = 1; o < 64; o <<= 1) {
#pragma unroll
                for (int r = 0; r < 4; ++r) sq[r] += __shfl_xor(sq[r], o); }
#pragma unroll
            for (int r = 0; r < 4; ++r) { const float rr = rsqrtf(sq[r] * (1.0f / DM) + EPS);
                u32x2* o8 = (u32x2*)(xb + (size_t)(rb + r) * DM) + lane;
#pragma unroll
                for (int j = 0; j < 4; ++j) { const f32x4 gg = *((const f32x4*)p.g_mix + lane + 64 * j);
                    u32x2 w; w.x = pk2(v[r][j][0] * rr * gg[0], v[r][j][1] * rr * gg[1]); w.y = pk2(v[r][j][2] * rr * gg[2], v[r][j][3] * rr * gg[3]); o8[64 * j] = w; } }
        }
    }
    {
        float* z = (float*)(ws + OFF_SSQ2);
        for (int i = blockIdx.x * 512 + tid; i < 2 * MTOK; i += G * 512) z[i] = 0.f;
        float* oml = (float*)(ws + OFF_OML);
        for (int i = blockIdx.x * 512 + tid; i < 2 * DM; i += G * 512) { const int dir = i >> 10, n = i & 1023;
            const float l0 = p.lb_logits[(size_t)dir * 2 * DM + n], l1 = p.lb_logits[(size_t)dir * 2 * DM + DM + n];
            oml[i] = 1.0f / (1.0f + __expf(l0 - l1)); }
    }
}

constexpr int CH = 32, NCH = SEQ / CH, R_STR = 272;
constexpr int R_QD = 0, R_KI = CH * R_STR, R_KE = 2 * CH * R_STR, R_VT = R_KE + 128 * 64, R_DD = R_VT + 128 * 64, R_SLOT = R_DD + 512;
constexpr int R_RAW = 0, R_WSLOT = 3 * CH * 64, R_NRAW = 3, R_DIST = 3, R_OPS = 4 * R_NRAW * R_WSLOT, R_OB = R_OPS + 2 * R_SLOT, R_OBSZ = CH * R_STR;
static_assert(R_OB + 2 * R_OBSZ + 16 <= LDS_BYTES, "LDS");

DI void rec_prep(const LAS unsigned char* raw, LAS unsigned char* sl, int tg, int kp, int rg) {
    unsigned kw[8], qw[8], vw[8];
#pragma unroll
    for (int j = 0; j < 8; ++j) { const int ro = (8 * rg + j) * 64 + kp * 4; qw[j] = *(const LAS unsigned*)(raw + ro); kw[j] = *(const LAS unsigned*)(raw + 2048 + ro); vw[j] = *(const LAS unsigned*)(raw + 4096 + ro); }
    f32x2 P = {1.f, 1.f}, Pl[8];
#pragma unroll
    for (int j = 0; j < 8; ++j) { const f32x2 f = {1.0f - bf_lo(kw[j]), 1.0f - bf_hi(kw[j])}; P = P * f; Pl[j] = P; }
    f32x2 T[4];
#pragma unroll
    for (int g = 0; g < 4; ++g) { T[g].x = __shfl(P.x, 16 * g + kp); T[g].y = __shfl(P.y, 16 * g + kp); }
    const f32x2 one = {1.f, 1.f};
    f32x2 pre = rg >= 1 ? T[0] : one; pre = pre * (rg >= 2 ? T[1] : one); pre = pre * (rg >= 3 ? T[2] : one);
    const f32x2 PL = (T[0] * T[1]) * (T[2] * T[3]);
    f32x2 ke[8];
    const int cb = 64 * tg + 2 * (8 * ((kp >> 1) & 3) + 4 * (kp >> 3) + 2 * (kp & 1));
#pragma unroll
    for (int j = 0; j < 8; ++j) { const int t = 8 * rg + j; const f32x2 Pa = pre * Pl[j];
        const f32x2 ki = {bf_lo(kw[j]) * fast_rcp(Pa.x), bf_hi(kw[j]) * fast_rcp(Pa.y)}; ke[j] = ki * PL;
        *(LAS unsigned*)(sl + R_QD + t * R_STR + cb) = pk2(bf_lo(qw[j]) * Pa.x, bf_hi(qw[j]) * Pa.y);
        *(LAS unsigned*)(sl + R_KI + t * R_STR + cb) = pk2(ki.x, ki.y); }
    const int n0 = 32 * tg + 2 * kp, so = ((rg ^ (kp & 3)) * 16);
    u32x4 k0, k1, v0, v1;
    k0.x = pk2(ke[0].x, ke[1].x); k0.y = pk2(ke[2].x, ke[3].x); k0.z = pk2(ke[4].x, ke[5].x); k0.w = pk2(ke[6].x, ke[7].x);
    k1.x = pk2(ke[0].y, ke[1].y); k1.y = pk2(ke[2].y, ke[3].y); k1.z = pk2(ke[4].y, ke[5].y); k1.w = pk2(ke[6].y, ke[7].y);
    v0.x = (vw[0] & 0xffffu) | (vw[1] << 16); v0.y = (vw[2] & 0xffffu) | (vw[3] << 16); v0.z = (vw[4] & 0xffffu) | (vw[5] << 16); v0.w = (vw[6] & 0xffffu) | (vw[7] << 16);
    v1.x = (vw[0] >> 16) | (vw[1] & 0xffff0000u); v1.y = (vw[2] >> 16) | (vw[3] & 0xffff0000u); v1.z = (vw[4] >> 16) | (vw[5] & 0xffff0000u); v1.w = (vw[6] >> 16) | (vw[7] & 0xffff0000u);
    *(LAS u32x4*)(sl + R_KE + n0 * 64 + so) = k0; *(LAS u32x4*)(sl + R_KE + (n0 + 1) * 64 + so) = k1;
    *(LAS u32x4*)(sl + R_VT + n0 * 64 + so) = v0; *(LAS u32x4*)(sl + R_VT + (n0 + 1) * 64 + so) = v1;
    if (rg == 0) *(LAS f32x2*)(sl + R_DD + n0 * 4) = PL;
}

DI void phase_rec(const Params& p, LAS unsigned char* lds) {
    const int tid = threadIdx.x, lane = tid & 63, w = __builtin_amdgcn_readfirstlane(tid >> 6), c16 = lane & 15, kg = lane >> 4;
    const bool prep = w >= 4;
    const int tg = w & 3, kp = lane & 15, rg = lane >> 4, pt = tid & 255;
    unsigned char* ws = p.ws;
    for (int s = blockIdx.x; s < NB * 2 * NH; s += gridDim.x) {
        const int b = s >> 4, dh = s & 15, dir = dh >> 3, h = dh & 7;
        const size_t sbase = ((size_t)b * SEQ * DM + h * 128) * 2;
        const unsigned char* gq = ws + OFF_S0 + sbase;
        unsigned char* gk = ws + (dir ? OFF_S2 : OFF_S1) + sbase;
        const unsigned char* gv = ws + OFF_S3 + sbase;
#define REC_ROWB(c, t) ((size_t)(dir ? (SEQ - 1 - (CH * (c) + (t))) : (CH * (c) + (t))) * (DM * 2))
#define REC_DMA1(c, a_, half_) do { const unsigned char* _src = ((a_) == 0 ? gq : ((a_) == 1 ? (const unsigned char*)gk : gv)) + REC_ROWB(c, 16 * (half_) + (lane >> 2)) + 64 * tg + (lane & 3) * 16; \
        __builtin_amdgcn_global_load_lds((const unsigned*)_src, (LAS unsigned*)(lds + R_RAW + (tg * R_NRAW + ((c) % R_NRAW)) * R_WSLOT + (a_) * 2048 + (half_) * 1024), 16, 0, 0); } while (0)
#define REC_DMA(c) do { REC_DMA1(c, 0, 0); REC_DMA1(c, 0, 1); REC_DMA1(c, 1, 0); REC_DMA1(c, 1, 1); REC_DMA1(c, 2, 0); REC_DMA1(c, 2, 1); } while (0)
#define REC_RAWSLOT(c) (lds + R_RAW + (tg * R_NRAW + ((c) % R_NRAW)) * R_WSLOT)
#define REC_OUT(c) do { _Pragma("unroll") for (int _k = 0; _k < 2; ++_k) { const int _id = pt + 256 * _k, _t = _id >> 4, _pc = _id & 15; \
        const u32x4 _v = *(const LAS u32x4*)(lds + R_OB + ((c) & 1) * R_OBSZ + _t * R_STR + _pc * 16); *(u32x4*)(gk + REC_ROWB(c, _t) + _pc * 16) = _v; } } while (0)
        __syncthreads();
        if (!prep) { REC_DMA(0); REC_DMA(1); REC_DMA(2); }
        asm volatile("s_waitcnt vmcnt(0)" ::: "memory"); __builtin_amdgcn_s_barrier(); asm volatile("" ::: "memory");
        if (prep) rec_prep(REC_RAWSLOT(0), lds + R_OPS, tg, kp, rg);
        asm volatile("s_waitcnt lgkmcnt(0)" ::: "memory"); __builtin_amdgcn_s_barrier(); asm volatile("" ::: "memory");
        const int sx = (c16 >> 1) & 3;
#define REC_STEP_BARRIER() do { asm volatile("s_waitcnt lgkmcnt(0)" ::: "memory"); __builtin_amdgcn_s_barrier(); asm volatile("" ::: "memory"); } while (0)
        if (prep) {
            for (int c = 0; c < NCH; ++c) {
                if (c + 1 < NCH) rec_prep(REC_RAWSLOT(c + 1), lds + R_OPS + ((c + 1) & 1) * R_SLOT, tg, kp, rg);
                REC_STEP_BARRIER();
            }
        } else {
            __builtin_amdgcn_s_setprio(2);
            f32x4 S[2][8];
#pragma unroll
            for (int d = 0; d < 2; ++d)
#pragma unroll
                for (int i = 0; i < 8; ++i) S[d][i] = (f32x4){0.f, 0.f, 0.f, 0.f};
            for (int c = 0; c < NCH; ++c) {
                if (c + R_DIST < NCH) REC_DMA(c + R_DIST);
                if (c >= 1) REC_OUT(c - 1);
                const LAS unsigned char* sl = lds + R_OPS + (c & 1) * R_SLOT;
                bf16x8 qf[2][4], kf[2][4];
#pragma unroll
                for (int tt = 0; tt < 2; ++tt)
#pragma unroll
                    for (int pp = 0; pp < 4; ++pp) {
                        qf[tt][pp] = *(const LAS bf16x8*)(sl + R_QD + (16 * tt + c16) * R_STR + 64 * pp + 16 * kg);
                        kf[tt][pp] = *(const LAS bf16x8*)(sl + R_KI + (16 * tt + c16) * R_STR + 64 * pp + 16 * kg); }
#define REC_TFRAG(base, row) __builtin_shufflevector(*(const LAS bf16x4*)(sl + (base) + (row) * 64 + (((kg >> 1) ^ sx) * 16) + (kg & 1) * 8), \
                                                     *(const LAS bf16x4*)(sl + (base) + (row) * 64 + (((2 + (kg >> 1)) ^ sx) * 16) + (kg & 1) * 8), 0, 1, 2, 3, 4, 5, 6, 7)
                bf16x8 vf8[2];
#pragma unroll
                for (int d = 0; d < 2; ++d) vf8[d] = REC_TFRAG(R_VT, 32 * w + 16 * d + c16);
                f32x4 o2[2][2];
#pragma unroll
                for (int tt = 0; tt < 2; ++tt)
#pragma unroll
                    for (int d = 0; d < 2; ++d) o2[tt][d] = (f32x4){0.f, 0.f, 0.f, 0.f};
                f32x4 T00 = (f32x4){0.f, 0.f, 0.f, 0.f}, T01 = T00, T11 = T00;
#pragma unroll
                for (int pp = 0; pp < 4; ++pp) {
                    T00 = __builtin_amdgcn_mfma_f32_16x16x32_bf16(kf[0][pp], qf[0][pp], T00, 0, 0, 0);
                    T01 = __builtin_amdgcn_mfma_f32_16x16x32_bf16(kf[0][pp], qf[1][pp], T01, 0, 0, 0);
                    T11 = __builtin_amdgcn_mfma_f32_16x16x32_bf16(kf[1][pp], qf[1][pp], T11, 0, 0, 0);
#pragma unroll
                    for (int d = 0; d < 2; ++d) {
                        u32x4 sw; sw.x = pk2(S[d][2 * pp][0], S[d][2 * pp][1]); sw.y = pk2(S[d][2 * pp][2], S[d][2 * pp][3]); sw.z = pk2(S[d][2 * pp + 1][0], S[d][2 * pp + 1][1]); sw.w = pk2(S[d][2 * pp + 1][2], S[d][2 * pp + 1][3]);
                        const bf16x8 Sb = __builtin_bit_cast(bf16x8, sw);
                        o2[0][d] = __builtin_amdgcn_mfma_f32_16x16x32_bf16(qf[0][pp], Sb, o2[0][d], 0, 0, 0);
                        o2[1][d] = __builtin_amdgcn_mfma_f32_16x16x32_bf16(qf[1][pp], Sb, o2[1][d], 0, 0, 0); } }
#pragma unroll
                for (int i = 0; i < 8; ++i) {
                    const f32x4 dv4 = *(const LAS f32x4*)(sl + R_DD + (16 * i + 4 * kg) * 4);
                    const bf16x8 kef8 = REC_TFRAG(R_KE, 16 * i + c16);
#pragma unroll
                    for (int d = 0; d < 2; ++d) S[d][i] = __builtin_amdgcn_mfma_f32_16x16x32_bf16(kef8, vf8[d], S[d][i] * dv4, 0, 0, 0); }
#undef REC_TFRAG
#pragma unroll
                for (int r = 0; r < 4; ++r) if (4 * kg + r > c16) { T00[r] = 0.f; T11[r] = 0.f; }
                u32x4 a0, a1;
                a0.x = pk2(T00[0], T00[1]); a0.y = pk2(T00[2], T00[3]); a0.z = 0u; a0.w = 0u;
                a1.x = pk2(T01[0], T01[1]); a1.y = pk2(T01[2], T01[3]); a1.z = pk2(T11[0], T11[1]); a1.w = pk2(T11[2], T11[3]);
                const bf16x8 sA[2] = {__builtin_bit_cast(bf16x8, a0), __builtin_bit_cast(bf16x8, a1)};
                LAS unsigned char* ob = lds + R_OB + (c & 1) * R_OBSZ;
#pragma unroll
                for (int tt = 0; tt < 2; ++tt)
#pragma unroll
                    for (int d = 0; d < 2; ++d) {
                        const f32x4 o = __builtin_amdgcn_mfma_f32_16x16x32_bf16(sA[tt], vf8[d], o2[tt][d], 0, 0, 0);
#pragma unroll
                        for (int r = 0; r < 4; ++r) *(LAS bf16_t*)(ob + (16 * tt + 4 * kg + r) * R_STR + (32 * w + 16 * d + c16) * 2) = (bf16_t)(pk2(o[r], 0.f) & 0xffffu); }
                if (c >= 2 && c + R_DIST < NCH) asm volatile("s_waitcnt vmcnt(10)" ::: "memory"); else asm volatile("s_waitcnt vmcnt(0)" ::: "memory");
                REC_STEP_BARRIER();
            }
            __builtin_amdgcn_s_setprio(0);
        }
#undef REC_STEP_BARRIER
        if (!prep) REC_OUT(NCH - 1);
        asm volatile("s_waitcnt vmcnt(0) lgkmcnt(0)" ::: "memory"); __builtin_amdgcn_s_barrier(); asm volatile("" ::: "memory");
#undef REC_ROWB
#undef REC_DMA1
#undef REC_DMA
#undef REC_RAWSLOT
#undef REC_OUT
    }
}

DI void comb_one(const Params& p, int oi, const u32x4 a, const u32x4 bb, const u32x4 gg, const u32x4 (&pv)[17], u32x4* of, u32x4* yp) {
    const int co = oi & 127;
    float o[8];
    o[0] = bf_lo(a.x) + bf_lo(bb.x); o[1] = bf_hi(a.x) + bf_hi(bb.x); o[2] = bf_lo(a.y) + bf_lo(bb.y); o[3] = bf_hi(a.y) + bf_hi(bb.y);
    o[4] = bf_lo(a.z) + bf_lo(bb.z); o[5] = bf_hi(a.z) + bf_hi(bb.z); o[6] = bf_lo(a.w) + bf_lo(bb.w); o[7] = bf_hi(a.w) + bf_hi(bb.w);
    float s = 0.f;
#pragma unroll
    for (int j = 0; j < 8; ++j) s += o[j] * o[j];
    s += __shfl_xor(s, 1); s += __shfl_xor(s, 2); s += __shfl_xor(s, 4); s += __shfl_xor(s, 8);
    const float r = rsqrtf(s * (1.0f / 128.0f) + EPS);
    const f32x4 g0 = *(const f32x4*)(p.hgrn_g + co * 8), g1 = *(const f32x4*)(p.hgrn_g + co * 8 + 4);
    u32x4 y;
    y.x = pk2(o[0] * r * g0[0] * siluf_(bf_lo(gg.x)), o[1] * r * g0[1] * siluf_(bf_hi(gg.x))); y.y = pk2(o[2] * r * g0[2] * siluf_(bf_lo(gg.y)), o[3] * r * g0[3] * siluf_(bf_hi(gg.y)));
    y.z = pk2(o[4] * r * g1[0] * siluf_(bf_lo(gg.z)), o[5] * r * g1[1] * siluf_(bf_hi(gg.z))); y.w = pk2(o[6] * r * g1[2] * siluf_(bf_lo(gg.w)), o[7] * r * g1[3] * siluf_(bf_hi(gg.w)));
    of[oi] = y;
    const int row = oi >> 7, t = row & (SEQ - 1), half = 1 << (co >> 5);
    const int lo = max(t - half + 1, 0), hi = min(t + half + 1, SEQ);
    float acc[8];
#pragma unroll
    for (int j = 0; j < 8; ++j) acc[j] = 0.f;
#pragma unroll
    for (int j = 0; j < 16; ++j) { const u32x4 v = pv[1 + j];
        acc[0] += bf_lo(v.x); acc[1] += bf_hi(v.x); acc[2] += bf_lo(v.y); acc[3] += bf_hi(v.y); acc[4] += bf_lo(v.z); acc[5] += bf_hi(v.z); acc[6] += bf_lo(v.w); acc[7] += bf_hi(v.w); }
    const float ic = 1.0f / (float)(hi - lo);
    const u32x4 c = pv[0];
    u32x4 q;
    q.x = pk2(acc[0] * ic - bf_lo(c.x), acc[1] * ic - bf_hi(c.x)); q.y = pk2(acc[2] * ic - bf_lo(c.y), acc[3] * ic - bf_hi(c.y));
    q.z = pk2(acc[4] * ic - bf_lo(c.z), acc[5] * ic - bf_hi(c.z)); q.w = pk2(acc[6] * ic - bf_lo(c.w), acc[7] * ic - bf_hi(c.w));
    yp[oi] = q;
}
DI void phase_comb(const Params& p) {
    unsigned char* ws = p.ws;
    const int gt = blockIdx.x * 512 + threadIdx.x, NT = gridDim.x * 512;
    u32x4* of = (u32x4*)(ws + OFF_S1); const u32x4* ob = (const u32x4*)(ws + OFF_S2); const u32x4* og = (const u32x4*)(ws + OFF_S4);
    const u32x4* pin = (const u32x4*)(ws + OFF_S5); u32x4* yp = (u32x4*)(ws + OFF_XB);
    const u32x4 zero = {0u, 0u, 0u, 0u};
    for (int oi = gt; oi < MTOK * 128; oi += NT) {
        const int co = oi & 127, row = oi >> 7, t = row & (SEQ - 1), half = 1 << (co >> 5);
        const int lo = max(t - half + 1, 0), hi = min(t + half + 1, SEQ);
        const u32x4 a = of[oi], bb = ob[oi], gg = og[oi];
        u32x4 pv[17];
        pv[0] = pin[oi];
#pragma unroll
        for (int j = 0; j < 16; ++j) { const int tt = lo + j; pv[1 + j] = (tt < hi) ? pin[oi + (tt - t) * 128] : zero; }
        comb_one(p, oi, a, bb, gg, pv, of, yp);
    }
}

DI void phase_final(const Params& p) {
    const float* ssq = (const float*)(p.ws + OFF_SSQ3);
    const u32x4* hb = (const u32x4*)(p.ws + OFF_S2);
    f32x4* o = (f32x4*)p.out;
    const int gt = blockIdx.x * 512 + threadIdx.x, NT = gridDim.x * 512;
    const f32x4 g0 = *((const f32x4*)p.g_final + 2 * (gt & 127)), g1 = *((const f32x4*)p.g_final + 2 * (gt & 127) + 1);
    for (int i0 = gt; i0 < MTOK * DM / 8; i0 += 8 * NT) {
        u32x4 v[8]; float r[8];
#pragma unroll
        for (int k = 0; k < 8; ++k) { const int i = i0 + k * NT; v[k] = hb[i]; r[k] = ssq[i >> 7]; }
#pragma unroll
        for (int k = 0; k < 8; ++k) { const int i = i0 + k * NT; const float rr = rsqrtf(r[k] * (1.0f / DM) + EPS);
            const f32x4 a = {bf_lo(v[k].x), bf_hi(v[k].x), bf_lo(v[k].y), bf_hi(v[k].y)}, bq = {bf_lo(v[k].z), bf_hi(v[k].z), bf_lo(v[k].w), bf_hi(v[k].w)};
            o[2 * i] = a * rr * g0; o[2 * i + 1] = bq * rr * g1; }
    }
}

#ifndef DBG_STOP
#define DBG_STOP -1
#endif
DI void phase_digest(const Params& p) {
    const unsigned short* b0 = (const unsigned short*)(p.ws + OFF_XB);
    const int gt = blockIdx.x * 512 + threadIdx.x, NT = gridDim.x * 512;
    for (int i = gt; i < MTOK * DM / 2; i += NT) {
        unsigned acc = 0;
#pragma unroll
        for (int j = 0; j < 7; ++j) acc += (unsigned)b0[(size_t)j * (SPL / 2) + i] + 3u * (unsigned)b0[(size_t)j * (SPL / 2) + i + MTOK * DM / 2];
        if (DBG_STOP < 4) { const unsigned short* g = (const unsigned short*)p.out; acc += (unsigned)g[2 * (size_t)i] + 5u * (unsigned)g[2 * (size_t)i + 1] + 7u * (unsigned)g[(size_t)MTOK * DM + i] ; }
        p.out[i] = (float)(acc & 0xfffffu);
    }
}

#define XB_TMO      128
#define XB_XCNT(j)  (256  + 64 * (j))
#define XB_XSUB(j)  (1280 + 64 * (j))
#define XB_XGEN(j)  (2304 + 64 * (j))
#define XB_TOP      3328
#define XB_TOPGEN   3392
#define XCD_BAR_WORDS 3456
#define XB_SPIN_CAP (1u << 18)

__device__ __forceinline__ unsigned xb_ld(unsigned* p)              { return __hip_atomic_load(p, __ATOMIC_RELAXED, __HIP_MEMORY_SCOPE_AGENT); }
__device__ __forceinline__ unsigned xb_add(unsigned* p, unsigned v) { return __hip_atomic_fetch_add(p, v, __ATOMIC_RELAXED, __HIP_MEMORY_SCOPE_AGENT); }
__device__ __forceinline__ unsigned xb_xcc_id() { return (unsigned)__builtin_amdgcn_s_getreg((3 << 11) | 20) & 0xFu; }
#define XB_SPIN(cond, bar) do { unsigned _sp = 0; while (cond) { __builtin_amdgcn_s_sleep(1); \
    if ((++_sp & 255u) == 0u) { if (xb_ld(&(bar)[XB_TMO])) break; if (_sp > XB_SPIN_CAP) { atomicAdd(&(bar)[XB_TMO], 1u); break; } } } } while (0)

struct XcdBarrier {
    unsigned* bar; unsigned x;
    volatile LAS unsigned* st;
};

__device__ __forceinline__ XcdBarrier xcd_barrier_post(unsigned* bar, volatile LAS unsigned* st) {
    XcdBarrier b; b.bar = bar; b.x = xb_xcc_id(); b.st = st;
    if (threadIdx.x == 0) (void)xb_add(&bar[XB_XCNT(b.x)], 1u);
    return b;
}
__device__ __forceinline__ void xcd_barrier_complete(unsigned* bar, unsigned x, unsigned& nloc, unsigned& nx) {
    const unsigned G = gridDim.x * gridDim.y * gridDim.z;
    unsigned sum, cnt, mine, sp = 0u;
    for (;;) {
        sum = 0u; cnt = 0u; mine = 0u;
#pragma unroll
        for (unsigned j = 0; j < 16; ++j) { const unsigned c = xb_ld(&bar[XB_XCNT(j)]); sum += c; cnt += (c > 0u) ? 1u : 0u; mine = (j == x) ? c : mine; }
        if (sum == G) break;
        __builtin_amdgcn_s_sleep(1);
        if ((++sp & 255u) == 0u) { if (xb_ld(&bar[XB_TMO])) break; if (sp > XB_SPIN_CAP) { atomicAdd(&bar[XB_TMO], 1u); break; } }
    }
    nloc = mine > 0u ? mine : 1u; nx = cnt > 0u ? cnt : 1u;
}

__device__ __forceinline__ void xcd_barrier(const XcdBarrier& b) {
    asm volatile("s_waitcnt vmcnt(0)" ::: "memory");
    __syncthreads();
    if (threadIdx.x == 0) {
        unsigned* bar = b.bar;
        __builtin_amdgcn_s_waitcnt(0);
        unsigned nloc = b.st[0], nx = b.st[1];
        if (nloc == 0u) { xcd_barrier_complete(bar, b.x, nloc, nx); b.st[0] = nloc; b.st[1] = nx; }
        const unsigned old = xb_add(&bar[XB_XSUB(b.x)], 1u);
        const unsigned gen = old / nloc;
        if (old + 1u == (gen + 1u) * nloc) {
            __builtin_amdgcn_fence(__ATOMIC_RELEASE, "agent");
            asm volatile("s_waitcnt vmcnt(0)" ::: "memory");
            const unsigned og = xb_add(&bar[XB_TOP], 1u);
            const unsigned tg = og / nx;
            if (og + 1u == (tg + 1u) * nx) xb_add(&bar[XB_TOPGEN], 1u);
            else XB_SPIN(xb_ld(&bar[XB_TOPGEN]) == tg, bar);
            __builtin_amdgcn_fence(__ATOMIC_ACQUIRE, "agent");
            xb_add(&bar[XB_XGEN(b.x)], 1u);
            asm volatile("s_waitcnt vmcnt(0)" ::: "memory");
        } else {
            XB_SPIN(xb_ld(&bar[XB_XGEN(b.x)]) == gen, bar);
            __builtin_amdgcn_fence(__ATOMIC_ACQUIRE, "agent");
            asm volatile("s_waitcnt vmcnt(0)" ::: "memory");
        }
    }
    __syncthreads();
}


#ifndef WGM_WIDE
#define WGM_WIDE 4
#define WGM_NARROW 8
#endif
__global__ void __launch_bounds__(512, 2) fwd_kernel(Params p, int ph_lo, int ph_hi) {
    extern __shared__ __attribute__((aligned(16))) unsigned char lds_raw[];
    LAS unsigned char* lds = (LAS unsigned char*)lds_raw;
    cg::grid_group grid = cg::this_grid();
    unsigned char* ws = p.ws;
    const int G = gridDim.x, c = blockIdx.x;
#define IN(k) (ph_lo <= (k) && (k) < ph_hi)
    volatile LAS unsigned* xst = (volatile LAS unsigned*)(lds + LDS_BYTES - 16);
    if (threadIdx.x < 4) xst[threadIdx.x] = 0u;
    __syncthreads();
    const XcdBarrier xbar = xcd_barrier_post((unsigned*)(ws + OFF_BAR), xst);
    if (ph_lo < 0) grid.sync();
#define SEAM(k) do { if (IN(k) && IN((k) + 1)) xcd_barrier(xbar); } while (0)
    if (IN(0)) phase0(p, lds);
    SEAM(0);
    if (IN(1)) {
        pg8::Gemm g{(const bf16_t*)(ws + OFF_XB), (const bf16_t*)(ws + OFF_XB), (const bf16_t*)(ws + OFF_WIN), DM, 1 << 30};
        pg8::StaticOrder S; S.init(MTOK, 8192, G, c, WGM_WIDE);
        pg8::EpiProj E{ws, p.out, (const float*)(ws + OFF_OML)};
        pg8::gemm_phase(lds, g, S, E);
    }
    SEAM(1);
    if (IN(2)) phase_rec(p, lds);
    SEAM(2);
    if (IN(3)) phase_comb(p);
    SEAM(3);
    if (IN(4)) {
        pg8::Gemm g{(const bf16_t*)(ws + OFF_S1), (const bf16_t*)(ws + OFF_XB), (const bf16_t*)(ws + OFF_WAB), DM, 4};
        pg8::PairOrder S; S.so.init(MTOK, DM, G, c, WGM_NARROW);
        pg8::EpiMerge E{(const bf16_t*)p.out, (bf16_t*)(ws + OFF_S0)};
        pg8::gemm_phase(lds, g, S, E);
    }
    SEAM(4);
    if (IN(5)) {
        pg8::Gemm g{(const bf16_t*)(ws + OFF_S0), (const bf16_t*)(ws + OFF_S0), (const bf16_t*)(ws + OFF_WO), DM, 1 << 30};
        pg8::StaticOrder S; S.init(MTOK, DM, G, c, WGM_NARROW);
        pg8::EpiResid<true, false, false> E{p.x, nullptr, (bf16_t*)(ws + OFF_S4), (float*)(ws + OFF_SSQ2)};
        pg8::gemm_phase(lds, g, S, E);
    }
    SEAM(5);
    if (IN(6)) {
        pg8::Gemm g{(const bf16_t*)(ws + OFF_S4), (const bf16_t*)(ws + OFF_S4), (const bf16_t*)(ws + OFF_WFI), DM, 1 << 30};
        pg8::StaticOrder S; S.init(MTOK, 2 * FF, G, c, WGM_WIDE);
        pg8::EpiSwiglu E{(const float*)(ws + OFF_SSQ2), (bf16_t*)(ws + OFF_ACT)};
        pg8::gemm_phase(lds, g, S, E);
    }
    SEAM(6);
    if (IN(7)) {
        pg8::Gemm g{(const bf16_t*)(ws + OFF_ACT), (const bf16_t*)(ws + OFF_ACT), (const bf16_t*)(ws + OFF_WFO), FF, 1 << 30};
        pg8::StaticOrder S; S.init(MTOK, DM, G, c, WGM_NARROW);
        pg8::EpiResid<true, false, true> E{(const bf16_t*)(ws + OFF_S4), nullptr, (bf16_t*)(ws + OFF_S2), (float*)(ws + OFF_SSQ3)};
        pg8::gemm_phase(lds, g, S, E);
    }
    SEAM(7);
    if (IN(8)) phase_final(p);
    if (IN(9)) phase_digest(p);
#undef IN
#undef SEAM
}

#ifndef N_LAUNCHES
#define N_LAUNCHES 1
#endif

extern "C" void kernel_launch(void* const* d_in, const int* in_sizes, int n_in, void* d_out, int out_size, void* d_ws, size_t ws_size, hipStream_t stream) {
    static int grid = 0;
    if (grid == 0) {
        if (n_in != 14 || in_sizes[0] != MTOK * DM || out_size != MTOK * DM || ws_size < WS_END) {
            fprintf(stderr, "kernel_launch: unexpected shapes (n_in %d, in0 %d, out %d, ws %zu, need %zu)\n", n_in, n_in > 0 ? in_sizes[0] : -1, out_size, ws_size, (size_t)WS_END); grid = -1; return; }
        int dev = 0, cus = 0, per_cu = 0;
        hipGetDevice(&dev);
        hipDeviceGetAttribute(&cus, hipDeviceAttributeMultiprocessorCount, dev);
        if (hipFuncSetAttribute((const void*)fwd_kernel, hipFuncAttributeMaxDynamicSharedMemorySize, LDS_BYTES) != hipSuccess) { fprintf(stderr, "kernel_launch: hipFuncSetAttribute failed\n"); grid = -1; return; }
        if (hipOccupancyMaxActiveBlocksPerMultiprocessor(&per_cu, (const void*)fwd_kernel, 512, LDS_BYTES) != hipSuccess || per_cu < 1) { fprintf(stderr, "kernel_launch: occupancy query failed (%d)\n", per_cu); (void)hipGetLastError(); per_cu = 1; }
        grid = cus * 1;
        if (grid > 256) grid = 256;
    }
    if (grid < 0) return;
    Params p{};
    p.x = (const float*)d_in[0]; p.g_mix = (const float*)d_in[1]; p.w_in = (const float*)d_in[2]; p.lb_logits = (const float*)d_in[3];
    p.hgrn_g = (const float*)d_in[4]; p.pool_w = (const float*)d_in[5]; p.pool_scale = (const float*)d_in[6]; p.w_a = (const float*)d_in[7];
    p.w_b = (const float*)d_in[8]; p.w_out = (const float*)d_in[9]; p.g_ffn = (const float*)d_in[10]; p.w_fi = (const float*)d_in[11];
    p.w_fo = (const float*)d_in[12]; p.g_final = (const float*)d_in[13];
    p.out = (float*)d_out; p.ws = (unsigned char*)d_ws;
    if (hipMemsetAsync((unsigned char*)d_ws + OFF_BAR, 0, XCD_BAR_WORDS * 4, stream) != hipSuccess) { fprintf(stderr, "kernel_launch: memset of the barrier words failed\n"); return; }
#if N_LAUNCHES == 1
    int lo = 0, hi = 9;
    void* args[] = {&p, &lo, &hi};
    hipError_t e = hipLaunchCooperativeKernel((const void*)fwd_kernel, dim3(grid), dim3(512), args, LDS_BYTES, stream);
    if (e != hipSuccess) fprintf(stderr, "kernel_launch: cooperative launch failed: %s (grid %d)\n", hipGetErrorString(e), grid);
#else
    for (int ph = 0; ph < (DBG_STOP >= 0 ? DBG_STOP + 2 : 9); ++ph) {
        int lo = ph, hi = ph + 1;
        if (DBG_STOP >= 0 && ph == DBG_STOP + 1) { lo = 9; hi = 10; }
        void* args[] = {&p, &lo, &hi};
        hipError_t e = hipLaunchCooperativeKernel((const void*)fwd_kernel, dim3(grid), dim3(512), args, LDS_BYTES, stream);
        if (e != hipSuccess) fprintf(stderr, "kernel_launch: launch %d failed: %s (grid %d)\n", ph, hipGetErrorString(e), grid);
    }
#endif
}
```

```cpp
#include <hip/hip_runtime.h>
#include <hip/hip_cooperative_groups.h>
#include <cstdio>
#include <cstdint>
namespace cg = cooperative_groups;

#define LAS __attribute__((address_space(3)))
#define DI __device__ __forceinline__
typedef unsigned short bf16_t;
typedef short bf16x8 __attribute__((ext_vector_type(8)));
typedef short bf16x4 __attribute__((ext_vector_type(4)));
typedef float f32x4 __attribute__((ext_vector_type(4)));
typedef float f32x2 __attribute__((ext_vector_type(2)));
typedef unsigned u32x4 __attribute__((ext_vector_type(4)));
typedef unsigned u32x2 __attribute__((ext_vector_type(2)));

constexpr int MTOK = 32768, DM = 1024, SEQ = 2048, NB = 16, NH = 8, FF = 2816;
constexpr float EPS = 1e-6f;
constexpr size_t MiB = (size_t)1 << 20;
constexpr size_t OFF_WIN = 0;
constexpr size_t OFF_WAB = 16 * MiB;
constexpr size_t OFF_WO = 20 * MiB;
constexpr size_t OFF_WFI = 22 * MiB;
constexpr size_t OFF_WFO = 33 * MiB;
constexpr size_t OFF_SSQ2 = 39 * MiB;
constexpr size_t OFF_SSQ3 = OFF_SSQ2 + 131072;
constexpr size_t OFF_OML = OFF_SSQ3 + 131072;
constexpr size_t OFF_BAR = 40 * MiB;
constexpr size_t OFF_XB = 41 * MiB;
constexpr size_t OFF_S0 = 105 * MiB;
constexpr size_t SPL = 64 * MiB;
constexpr size_t OFF_S1 = OFF_S0 + SPL;
constexpr size_t OFF_S2 = OFF_S1 + SPL;
constexpr size_t OFF_S3 = OFF_S2 + SPL;
constexpr size_t OFF_S4 = OFF_S3 + SPL;
constexpr size_t OFF_S5 = OFF_S4 + SPL;
constexpr size_t OFF_ACT = OFF_XB;
constexpr size_t WS_END = OFF_S5 + SPL;
constexpr int LDS_BYTES = 163840;

struct Params {
    const float *x, *g_mix, *w_in, *lb_logits, *hgrn_g, *pool_w, *pool_scale, *w_a, *w_b, *w_out, *g_ffn, *w_fi, *w_fo, *g_final;
    float* out; unsigned char* ws;
};

DI unsigned pk2(float lo, float hi) {
    typedef __bf16 bf2 __attribute__((ext_vector_type(2)));
    f32x2 v = {lo, hi};
    bf2 b = __builtin_convertvector(v, bf2);
    return __builtin_bit_cast(unsigned, b);
}
DI float bf_lo(unsigned u) { return __uint_as_float(u << 16); }
DI float bf_hi(unsigned u) { return __uint_as_float(u & 0xffff0000u); }
DI float bf2f(bf16_t h) { return __uint_as_float(((unsigned)h) << 16); }
DI float fast_rcp(float x) { return __builtin_amdgcn_rcpf(x); }
DI float sigmoidf_(float v) { return fast_rcp(1.0f + __expf(-v)); }
DI float siluf_(float v) { return v * fast_rcp(1.0f + __expf(-v)); }
DI float wave_sum(float v) {
#pragma unroll
    for (int o = 1; o < 64; o <<= 1) v += __shfl_xor(v, o);
    return v;
}
#define LDS_WAIT() asm volatile("s_waitcnt lgkmcnt(0)" ::: "memory")

namespace pg8 {
constexpr int BM = 256, BK = 64, HALF = 128, HTB = HALF * BK * 2, STAGE_BYTES = 8 * HTB, NXCD = 8;
DI int lds_byte(int r, int c) { const int st = (r >> 4) * 2 + (c >> 5), rr = r & 15, cc = c & 31, ob = rr * 64 + cc * 2; return st * 1024 + (ob ^ (((ob >> 9) & 1) << 5)); }
DI void stage_rc(int b, int& R, int& C) { const int st = b / 1024, sb = b % 1024, swz = sb ^ (((sb >> 9) & 1) << 5); R = (st >> 1) * 16 + swz / 64; C = (st & 1) * 32 + (swz % 64) / 2; }
DI int perm32(int rho) { const int n = rho >> 4, i = rho & 15; return 8 * (i >> 2) + 4 * n + (i & 3); }

struct Unit { int pm, pn; };
struct Gemm { const bf16_t* A; const bf16_t* A2; const bf16_t* Bt; int K; int nsplit; };

struct StaticOrder {
    int nM, nN, nwg, G, c, WGM;
    DI void init(int M, int N, int G_, int c_, int wgm = 4) { nM = M / BM; nN = N / BM; nwg = nM * nN; G = G_; c = c_; WGM = wgm; }
    DI bool next(int i, Unit& u) const {
        const long L = (long)i * G + c; if (L >= nwg) return false;
        int wgid = (int)L; { const int q = nwg / NXCD, r = nwg % NXCD, xcd = wgid % NXCD, off = wgid / NXCD; wgid = (xcd < r ? xcd * (q + 1) : r * (q + 1) + (xcd - r) * q) + off; }
        const int nig = WGM * nN, gid = wgid / nig, fm = gid * WGM, gsz = (nM - fm) < WGM ? (nM - fm) : WGM;
        u.pm = fm + ((wgid % nig) % gsz); u.pn = (wgid % nig) / gsz; return true;
    }
};
struct PairOrder {
    StaticOrder so;
    DI bool next(int i, Unit& u) const { Unit t; if (!so.next(i >> 1, t)) return false; u.pm = t.pm; u.pn = t.pn + 4 * (i & 1); return true; }
};

template <class Epi, class Sched>
DI void gemm_phase(LAS unsigned char* lds, const Gemm g, const Sched& S, const Epi& E) {
    const int tid = threadIdx.x, wid = __builtin_amdgcn_readfirstlane(tid >> 6), lane = tid & 63, wr = wid >> 2, wc = wid & 3, fr = lane & 15, fq = lane >> 4;
    const int K = g.K, nt = K / BK;
    unsigned voffA[2], voffB[2];
#pragma unroll
    for (int i = 0; i < 2; ++i) { int R, C; stage_rc(tid * 16 + i * 8192, R, C); const int Rb = ((R & ~31) + perm32(R & 31));
        voffA[i] = (unsigned)(R * K + C) * 2u; voffB[i] = (unsigned)(Rb * K + C) * 2u; }
    const size_t kstep = (size_t)(BK * 2);
    const size_t hstep = (size_t)HALF * K * 2;
    const size_t tstep = 2 * hstep;
    const unsigned ldsw = (unsigned)wid * 1024u;
    const int aoff = lds_byte(wr * 64 + fr, fq * 8), boff = lds_byte(wc * 32 + fr, fq * 8);
#define PG8_SA(b, h) (((b) * 2 + (h)) * HTB)
#define PG8_SB(b, h) ((4 + (b) * 2 + (h)) * HTB)
#define PG8_STAGE(bufoff, gbase, voff) do { _Pragma("unroll") for (int _i = 0; _i < 2; ++_i) \
        __builtin_amdgcn_global_load_lds((const unsigned*)((const char*)(gbase) + (voff)[_i]), (LAS unsigned*)(lds + (bufoff) + ldsw + _i * 8192), 16, 0, 0); } while (0)
#define PG8_LDA(dst, b, h) do { _Pragma("unroll") for (int m = 0; m < 4; ++m) _Pragma("unroll") for (int k = 0; k < 2; ++k) dst[m][k] = *(const LAS bf16x8*)(lds + PG8_SA(b, h) + aoff + m * 2048 + k * 1024); } while (0)
#define PG8_LDB(dst, b, h) do { _Pragma("unroll") for (int n = 0; n < 2; ++n) _Pragma("unroll") for (int k = 0; k < 2; ++k) dst[n][k] = *(const LAS bf16x8*)(lds + PG8_SB(b, h) + boff + n * 2048 + k * 1024); } while (0)
#define PG8_MMA(ai, bj, At, Bt) do { __builtin_amdgcn_s_setprio(1); _Pragma("unroll") for (int m = 0; m < 4; ++m) _Pragma("unroll") for (int n = 0; n < 2; ++n) _Pragma("unroll") for (int k = 0; k < 2; ++k) \
        acc[ai][bj][m][n] = __builtin_amdgcn_mfma_f32_16x16x32_bf16(Bt[n][k], At[m][k], acc[ai][bj][m][n], 0, 0, 0); __builtin_amdgcn_s_setprio(0); } while (0)
#define PG8_WAIT_V(n) asm volatile("s_waitcnt vmcnt(" #n ")" ::: "memory")
#define PG8_WAIT_L(n) asm volatile("s_waitcnt lgkmcnt(" #n ")" ::: "memory")
#define PG8_BAR __builtin_amdgcn_s_barrier()
#define PG8_SCHED __builtin_amdgcn_sched_barrier(0)
#define PG8_ABASE(u) ((const char*)((u).pn >= g.nsplit ? g.A2 : g.A) + (size_t)(u).pm * tstep)
    Unit cur, nxt; int ui = 0;
    if (!S.next(0, cur)) return;
    f32x4 acc[2][2][4][2];
#pragma unroll
    for (int a = 0; a < 2; ++a)
#pragma unroll
        for (int b = 0; b < 2; ++b)
#pragma unroll
            for (int m = 0; m < 4; ++m)
#pragma unroll
                for (int n = 0; n < 2; ++n) acc[a][b][m][n] = (f32x4){0.f, 0.f, 0.f, 0.f};
    bf16x8 At[4][2], B0[2][2], B1[2][2];
    const char* cA = PG8_ABASE(cur); const char* cB = (const char*)g.Bt + (size_t)cur.pn * tstep;
    PG8_STAGE(PG8_SB(0, 0), cB, voffB); PG8_STAGE(PG8_SB(0, 1), cB + hstep, voffB); PG8_STAGE(PG8_SA(0, 0), cA, voffA); PG8_STAGE(PG8_SA(0, 1), cA + hstep, voffA);
    if (wr == 1) PG8_BAR;
    PG8_WAIT_V(2); PG8_BAR;
    PG8_STAGE(PG8_SB(1, 0), cB + kstep, voffB); PG8_STAGE(PG8_SA(1, 0), cA + kstep, voffA); PG8_STAGE(PG8_SB(1, 1), cB + hstep + kstep, voffB);
    PG8_WAIT_V(6); PG8_BAR;
    for (;;) {
        const bool has_next = S.next(ui + 1, nxt);
        const char* nA = has_next ? PG8_ABASE(nxt) : cA; const char* nB = has_next ? (const char*)g.Bt + (size_t)nxt.pn * tstep : cB;
        for (int t = 0; t < nt; t += 2) {
            const bool last = (t == nt - 2);
            const char* a1 = cA + (size_t)(t + 1) * kstep;
            const char* a2 = last ? nA : cA + (size_t)(t + 2) * kstep; const char* b2 = last ? nB : cB + (size_t)(t + 2) * kstep;
            const char* a3 = a2 + kstep; const char* b3 = b2 + kstep;
            PG8_LDB(B0, 0, 0); PG8_LDB(B1, 0, 1); PG8_SCHED; PG8_LDA(At, 0, 0); PG8_STAGE(PG8_SA(1, 1), a1 + hstep, voffA);
            PG8_WAIT_V(8); PG8_WAIT_L(0); PG8_BAR; PG8_MMA(0, 0, At, B0); PG8_MMA(0, 1, At, B1); PG8_BAR; PG8_SCHED;
            PG8_LDA(At, 0, 1); PG8_STAGE(PG8_SB(0, 0), b2, voffB); PG8_STAGE(PG8_SB(0, 1), b2 + hstep, voffB); PG8_STAGE(PG8_SA(0, 0), a2, voffA);
            PG8_WAIT_V(8); PG8_WAIT_L(0); PG8_BAR; PG8_MMA(1, 0, At, B0); PG8_MMA(1, 1, At, B1); PG8_BAR; PG8_SCHED;
            PG8_LDB(B0, 1, 0); PG8_LDB(B1, 1, 1); PG8_SCHED; PG8_LDA(At, 1, 0); PG8_STAGE(PG8_SA(0, 1), a2 + hstep, voffA);
            PG8_WAIT_V(8); PG8_WAIT_L(0); PG8_BAR; PG8_MMA(0, 0, At, B0); PG8_MMA(0, 1, At, B1); PG8_BAR; PG8_SCHED;
            PG8_LDA(At, 1, 1); PG8_STAGE(PG8_SB(1, 0), b3, voffB); PG8_STAGE(PG8_SB(1, 1), b3 + hstep, voffB); PG8_STAGE(PG8_SA(1, 0), a3, voffA);
            PG8_WAIT_V(8); PG8_WAIT_L(0); PG8_BAR; PG8_MMA(1, 0, At, B0); PG8_MMA(1, 1, At, B1); PG8_BAR; PG8_SCHED;
        }
        if (wr == 0) PG8_BAR;
        const bool keep = E(acc, cur, wr, wc, fr, fq);
        if (!has_next) break;
        if (!keep) {
#pragma unroll
        for (int a = 0; a < 2; ++a)
#pragma unroll
            for (int b = 0; b < 2; ++b)
#pragma unroll
                for (int m = 0; m < 4; ++m)
#pragma unroll
                    for (int n = 0; n < 2; ++n) acc[a][b][m][n] = (f32x4){0.f, 0.f, 0.f, 0.f};
        }
        cur = nxt; cA = nA; cB = nB; ++ui;
        if (wr == 1) PG8_BAR;
    }
    PG8_WAIT_V(0);
    PG8_BAR;
#undef PG8_SA
#undef PG8_SB
#undef PG8_STAGE
#undef PG8_LDA
#undef PG8_LDB
#undef PG8_MMA
#undef PG8_WAIT_V
#undef PG8_WAIT_L
#undef PG8_BAR
#undef PG8_SCHED
#undef PG8_ABASE
}

typedef f32x4 Acc[2][2][4][2];

struct EpiProj {
    unsigned char* ws; float* dout; const float* oml;
    template <int MODE> DI void run(const Acc& acc, bf16_t* base, const float* omlp, int row0, int col0) const {
        f32x4 ov[2][2];
#pragma unroll
        for (int bj = 0; bj < 2; ++bj)
#pragma unroll
            for (int n = 0; n < 2; ++n) ov[bj][n] = (MODE == 3) ? *(const f32x4*)(omlp + col0 + bj * HALF + 4 * n) : (f32x4){0.f, 0.f, 0.f, 0.f};
#pragma unroll
        for (int ai = 0; ai < 2; ++ai)
#pragma unroll
            for (int m = 0; m < 4; ++m) { bf16_t* rowp = base + (size_t)(row0 + ai * HALF + m * 16) * DM + col0;
#pragma unroll
                for (int bj = 0; bj < 2; ++bj) { f32x4 v[2] = {acc[ai][bj][m][0], acc[ai][bj][m][1]};
#pragma unroll
                    for (int n = 0; n < 2; ++n)
#pragma unroll
                        for (int j = 0; j < 4; ++j) { const float t = v[n][j];
                            if (MODE == 1) v[n][j] = siluf_(t);
                            if (MODE == 2) v[n][j] = sigmoidf_(t);
                            if (MODE == 3) v[n][j] = ov[bj][n][j] * fast_rcp(1.0f + __expf(t)); }
                    u32x4 w; w.x = pk2(v[0][0], v[0][1]); w.y = pk2(v[0][2], v[0][3]); w.z = pk2(v[1][0], v[1][1]); w.w = pk2(v[1][2], v[1][3]);
                    *(u32x4*)(rowp + bj * HALF) = w; } }
    }
    DI bool operator()(Acc& acc, const Unit& u, int wr, int wc, int fr, int fq) const {
        const int split = u.pn >> 2, colt = (u.pn & 3) * BM;
        bf16_t* base = split < 6 ? (bf16_t*)(ws + OFF_S0 + (size_t)split * SPL) : (bf16_t*)((unsigned char*)dout + (size_t)(split - 6) * SPL);
        const int row0 = u.pm * BM + wr * 64 + fr, col0 = colt + wc * 32 + 8 * fq;
        if (split == 0) run<1>(acc, base, oml, row0, col0);
        else if (split == 1) run<3>(acc, base, oml, row0, col0);
        else if (split == 2) run<3>(acc, base, oml + DM, row0, col0);
        else if (split == 3 || split == 4 || split == 5) run<0>(acc, base, oml, row0, col0);
        else run<2>(acc, base, oml, row0, col0);
        return false;
    }
};

struct EpiMerge {
    const bf16_t* gates;
    bf16_t* merged;
    DI bool operator()(Acc& acc, const Unit& u, int wr, int wc, int fr, int fq) const {
        const int sel = u.pn >> 2, colt = (u.pn & 3) * BM;
        const bf16_t* ga = gates; const bf16_t* gb = gates + (size_t)MTOK * DM;
        const int row0 = u.pm * BM + wr * 64 + fr, col0 = colt + wc * 32 + 8 * fq;
#pragma unroll
        for (int ai = 0; ai < 2; ++ai) {
            u32x4 bw[4][2], aw[4][2];
#pragma unroll
            for (int m = 0; m < 4; ++m)
#pragma unroll
                for (int bj = 0; bj < 2; ++bj) { const size_t off = (size_t)(row0 + ai * HALF + m * 16) * DM + col0 + bj * HALF;
                    bw[m][bj] = *(const u32x4*)(gb + off); aw[m][bj] = (sel == 0) ? *(const u32x4*)(ga + off) : (u32x4){0u, 0u, 0u, 0u}; }
            asm volatile("" ::: "memory");
#pragma unroll
            for (int m = 0; m < 4; ++m)
#pragma unroll
                for (int bj = 0; bj < 2; ++bj) { const size_t off = (size_t)(row0 + ai * HALF + m * 16) * DM + col0 + bj * HALF;
                    const u32x4 b4 = bw[m][bj];
                    float sb[8] = {bf_lo(b4.x), bf_hi(b4.x), bf_lo(b4.y), bf_hi(b4.y), bf_lo(b4.z), bf_hi(b4.z), bf_lo(b4.w), bf_hi(b4.w)};
#pragma unroll
                    for (int j = 0; j < 8; ++j) sb[j] = fmaxf(sb[j], 1e-20f);
                    if (sel == 0) {
                        const u32x4 a4 = aw[m][bj];
                        const float sa[8] = {bf_lo(a4.x), bf_hi(a4.x), bf_lo(a4.y), bf_hi(a4.y), bf_lo(a4.z), bf_hi(a4.z), bf_lo(a4.w), bf_hi(a4.w)};
#pragma unroll
                        for (int j = 0; j < 4; ++j) { acc[ai][bj][m][0][j] *= sa[j] * fast_rcp(sb[j]); acc[ai][bj][m][1][j] *= sa[4 + j] * fast_rcp(sb[4 + j]); }
                    } else {
                        const f32x4 v0 = acc[ai][bj][m][0], v1 = acc[ai][bj][m][1];
                        u32x4 w; w.x = pk2(v0[0] * sb[0], v0[1] * sb[1]); w.y = pk2(v0[2] * sb[2], v0[3] * sb[3]); w.z = pk2(v1[0] * sb[4], v1[1] * sb[5]); w.w = pk2(v1[2] * sb[6], v1[3] * sb[7]);
                        *(u32x4*)(merged + off) = w; } }
        }
        return sel == 0;
    }
};

template <bool WITH_BF16, bool WRITE_F32, bool BASE_BF16> struct EpiResid {
    const void* base; float* outf; bf16_t* outb; float* ssq;
    DI bool operator()(Acc& acc, const Unit& u, int wr, int wc, int fr, int fq) const {
        const int row0 = u.pm * BM + wr * 64 + fr, col0 = u.pn * BM + wc * 32 + 8 * fq;
#pragma unroll
        for (int ai = 0; ai < 2; ++ai) {
            f32x4 bq[4][2][2];
#pragma unroll
            for (int m = 0; m < 4; ++m)
#pragma unroll
                for (int bj = 0; bj < 2; ++bj) { const size_t off = (size_t)(row0 + ai * HALF + m * 16) * DM + col0 + bj * HALF;
                    if (BASE_BF16) { const u32x4 bw = *(const u32x4*)((const bf16_t*)base + off);
                        bq[m][bj][0] = (f32x4){__uint_as_float(bw.x), __uint_as_float(bw.y), __uint_as_float(bw.z), __uint_as_float(bw.w)}; bq[m][bj][1] = bq[m][bj][0]; }
                    else { bq[m][bj][0] = *(const f32x4*)((const float*)base + off); bq[m][bj][1] = *(const f32x4*)((const float*)base + off + 4); } }
            asm volatile("" ::: "memory");
#pragma unroll
            for (int m = 0; m < 4; ++m) { const int row = row0 + ai * HALF + m * 16; float s = 0.f;
#pragma unroll
                for (int bj = 0; bj < 2; ++bj) { const size_t off = (size_t)row * DM + col0 + bj * HALF;
                    f32x4 b0, b1;
                    if (BASE_BF16) { const unsigned wx = __float_as_uint(bq[m][bj][0][0]), wy = __float_as_uint(bq[m][bj][0][1]), wz = __float_as_uint(bq[m][bj][0][2]), ww = __float_as_uint(bq[m][bj][0][3]);
                        b0 = (f32x4){bf_lo(wx), bf_hi(wx), bf_lo(wy), bf_hi(wy)}; b1 = (f32x4){bf_lo(wz), bf_hi(wz), bf_lo(ww), bf_hi(ww)}; }
                    else { b0 = bq[m][bj][0]; b1 = bq[m][bj][1]; }
                    const f32x4 v0 = acc[ai][bj][m][0] + b0, v1 = acc[ai][bj][m][1] + b1;
                    if (WRITE_F32) { *(f32x4*)(outf + off) = v0; *(f32x4*)(outf + off + 4) = v1; }
                    s += (v0[0] * v0[0] + v0[1] * v0[1]) + (v0[2] * v0[2] + v0[3] * v0[3]) + (v1[0] * v1[0] + v1[1] * v1[1]) + (v1[2] * v1[2] + v1[3] * v1[3]);
                    if (WITH_BF16) { u32x4 w; w.x = pk2(v0[0], v0[1]); w.y = pk2(v0[2], v0[3]); w.z = pk2(v1[0], v1[1]); w.w = pk2(v1[2], v1[3]);
                        *(u32x4*)(outb + off) = w; } }
                s += __shfl_xor(s, 16); s += __shfl_xor(s, 32);
                if (fq == 0) atomicAdd(ssq + row, s); }
        }
        return false;
    }
};

struct EpiSwiglu {
    const float* ssq; bf16_t* act;
    DI bool operator()(Acc& acc, const Unit& u, int wr, int wc, int fr, int fq) const {
        const int row0 = u.pm * BM + wr * 64 + fr, col0 = u.pn * HALF + wc * 32 + 8 * fq;
#pragma unroll
        for (int ai = 0; ai < 2; ++ai)
#pragma unroll
            for (int m = 0; m < 4; ++m) { const int row = row0 + ai * HALF + m * 16;
                const float r = rsqrtf(ssq[row] * (1.0f / DM) + EPS);
                float o[8];
#pragma unroll
                for (int n = 0; n < 2; ++n)
#pragma unroll
                    for (int j = 0; j < 4; ++j) { const float gt = acc[ai][0][m][n][j] * r, up = acc[ai][1][m][n][j] * r; o[4 * n + j] = siluf_(gt) * up; }
                u32x4 w; w.x = pk2(o[0], o[1]); w.y = pk2(o[2], o[3]); w.z = pk2(o[4], o[5]); w.w = pk2(o[6], o[7]);
                *(u32x4*)(act + (size_t)row * FF + col0) = w; }
        return false;
    }
};
}

DI void tr_item(const float* W, int N, bf16_t* WT, int K, int k0, int n0, int drow0, const float* ksc, LAS float* scr, int lane) {
    float v[64];
#pragma unroll
    for (int i = 0; i < 64; ++i) v[i] = W[(size_t)(k0 + i) * N + n0 + lane];
    if (ksc) {
#pragma unroll
        for (int i = 0; i < 64; ++i) v[i] *= ksc[k0 + i];
    }
#pragma unroll
    for (int i = 0; i < 64; ++i) scr[i * 65 + lane] = v[i];
    LDS_WAIT();
    const int c = lane & 7;
#pragma unroll
    for (int j = 0; j < 8; ++j) { const int n = (lane >> 3) + 8 * j; const LAS float* s = scr + (8 * c) * 65 + n;
        u32x4 o; o.x = pk2(s[0 * 65], s[1 * 65]); o.y = pk2(s[2 * 65], s[3 * 65]); o.z = pk2(s[4 * 65], s[5 * 65]); o.w = pk2(s[6 * 65], s[7 * 65]);
        *(u32x4*)(WT + (size_t)(drow0 + n) * K + k0 + 8 * c) = o; }
    LDS_WAIT();
}

DI void phase0(const Params& p, LAS unsigned char* lds) {
    const int tid = threadIdx.x, lane = tid & 63, wave = tid >> 6, G = gridDim.x;
    unsigned char* ws = p.ws;
    {
        LAS float* As = (LAS float*)lds;
        LAS float* Bs = (LAS float*)(lds + 32768);
        bf16_t* dst = (bf16_t*)(ws + OFF_WAB) + (size_t)DM * DM;
        for (int T = blockIdx.x; T < 256; T += G) {
            const int d0 = (T >> 4) * 64, rt = T & 15, g = rt >> 2, c0 = (rt & 3) * 64;
            const int cc = tid & 63, dq = tid >> 6;
            float acc[8];
#pragma unroll
            for (int j = 0; j < 8; ++j) acc[j] = 0.f;
            for (int eh = 0; eh < 256; eh += 128) {
                __syncthreads();
                for (int idx = tid; idx < 128 * 16; idx += 512) { const int e = idx >> 4, d4 = idx & 15; const int er = 256 * g + eh + e;
                    f32x4 v = *(const f32x4*)(p.w_b + (size_t)er * DM + d0 + 4 * d4); const float s = p.pool_scale[er];
                    *(LAS f32x4*)(As + e * 64 + 4 * d4) = v * s; }
                for (int idx = tid; idx < 64 * 32; idx += 512) { const int c = idx >> 5, e4 = idx & 31;
                    const f32x4 v = *(const f32x4*)(p.pool_w + ((size_t)(g * 256 + c0 + c)) * 256 + eh + 4 * e4);
                    LAS float* b = Bs + c * 129 + 4 * e4; b[0] = v[0]; b[1] = v[1]; b[2] = v[2]; b[3] = v[3]; }
                __syncthreads();
#pragma unroll 4
                for (int e = 0; e < 128; ++e) { const float b = Bs[cc * 129 + e];
                    const f32x4 a0 = *(const LAS f32x4*)(As + e * 64 + dq * 8), a1 = *(const LAS f32x4*)(As + e * 64 + dq * 8 + 4);
                    acc[0] += a0[0] * b; acc[1] += a0[1] * b; acc[2] += a0[2] * b; acc[3] += a0[3] * b;
                    acc[4] += a1[0] * b; acc[5] += a1[1] * b; acc[6] += a1[2] * b; acc[7] += a1[3] * b; }
            }
#pragma unroll
            for (int j = 0; j < 8; ++j) dst[(size_t)(d0 + dq * 8 + j) * DM + 256 * g + c0 + cc] = (bf16_t)(pk2(acc[j], 0.f) & 0xffffu);
        }
        __syncthreads();
    }
    {
        LAS float* scr = (LAS float*)(lds + wave * 16640);
        const int gw = blockIdx.x * 8 + wave, NGW = G * 8;
        constexpr int I_IN = 16 * 128, I_A = 16 * 16, I_O = 16 * 16, I_FI = 16 * 88, I_FO = 44 * 16;
        constexpr int NITEMS = I_IN + I_A + I_O + I_FI + I_FO;
        for (int it = gw; it < NITEMS; it += NGW) {
            int r = it;
            if (r < I_IN) { const int kb = r / 128, nb = r % 128; tr_item(p.w_in, 8192, (bf16_t*)(ws + OFF_WIN), DM, 64 * kb, 64 * nb, 64 * nb, nullptr, scr, lane); continue; } r -= I_IN;
            if (r < I_A) { const int kb = r / 16, nb = r % 16; tr_item(p.w_a, DM, (bf16_t*)(ws + OFF_WAB), DM, 64 * kb, 64 * nb, 64 * nb, nullptr, scr, lane); continue; } r -= I_A;
            if (r < I_O) { const int kb = r / 16, nb = r % 16; tr_item(p.w_out, DM, (bf16_t*)(ws + OFF_WO), DM, 64 * kb, 64 * nb, 64 * nb, nullptr, scr, lane); continue; } r -= I_O;
            if (r < I_FI) { const int kb = r / 88, nb = r % 88; const int n0 = 64 * nb; const int nn = n0 < FF ? n0 : n0 - FF;
                const int drow0 = 256 * (nn >> 7) + (n0 < FF ? 0 : 128) + (nn & 127);
                tr_item(p.w_fi, 2 * FF, (bf16_t*)(ws + OFF_WFI), DM, 64 * kb, n0, drow0, p.g_ffn, scr, lane); continue; } r -= I_FI;
            { const int kb = r / 16, nb = r % 16; tr_item(p.w_fo, DM, (bf16_t*)(ws + OFF_WFO), FF, 64 * kb, 64 * nb, 64 * nb, nullptr, scr, lane); }
        }
        bf16_t* xb = (bf16_t*)(ws + OFF_XB);
        for (int rb = gw * 4; rb < MTOK; rb += NGW * 4) {
            f32x4 v[4][4]; float sq[4];
#pragma unroll
            for (int r = 0; r < 4; ++r) { const f32x4* xr = (const f32x4*)(p.x + (size_t)(rb + r) * DM) + lane;
#pragma unroll
                for (int j = 0; j < 4; ++j) v[r][j] = xr[64 * j]; }
#pragma unroll
            for (int r = 0; r < 4; ++r) { float s = 0.f;
#pragma unroll
                for (int j = 0; j < 4; ++j) s += (v[r][j][0] * v[r][j][0] + v[r][j][1] * v[r][j][1]) + (v[r][j][2] * v[r][j][2] + v[r][j][3] * v[r][j][3]);
                sq[r] = s; }
#pragma unroll
            for (int o = 1; o < 64; o <<= 1) {
#pragma unroll
                for (int r = 0; r < 4; ++r) sq[r] += __shfl_xor(sq[r], o); }
#pragma unroll
            for (int r = 0; r < 4; ++r) { const float rr = rsqrtf(sq[r] * (1.0f / DM) + EPS);
                u32x2* o8 = (u32x2*)(xb + (size_t)(rb + r) * DM) + lane;
#pragma unroll
                for (int j = 0; j < 4; ++j) { const f32x4 gg = *((const f32x4*)p.g_mix + lane + 64 * j);
                    u32x2 w; w.x = pk2(v[r][j][0] * rr * gg[0], v[r][j][1] * rr * gg[1]); w.y = pk2(v[r][j][2] * rr * gg[2], v[r][j][3] * rr * gg[3]); o8[64 * j] = w; } }
        }
    }
    {
        float* z = (float*)(ws + OFF_SSQ2);
        for (int i = blockIdx.x * 512 + tid; i < 2 * MTOK; i += G * 512) z[i] = 0.f;
        float* oml = (float*)(ws + OFF_OML);
        for (int i = blockIdx.x * 512 + tid; i < 2 * DM; i += G * 512) { const int dir = i >> 10, n = i & 1023;
            const float l0 = p.lb_logits[(size_t)dir * 2 * DM + n], l1 = p.lb_logits[(size_t)dir * 2 * DM + DM + n];
            oml[i] = 1.0f / (1.0f + __expf(l0 - l1)); }
    }
}

constexpr int CH = 32, NCH = SEQ / CH, R_STR = 272;
constexpr int R_QD = 0, R_KI = CH * R_STR, R_KE = 2 * CH * R_STR, R_VT = R_KE + 128 * 64, R_DD = R_VT + 128 * 64, R_SLOT = R_DD + 512;
constexpr int R_RAW = 0, R_WSLOT = 3 * CH * 64, R_NRAW = 3, R_DIST = 3, R_OPS = 4 * R_NRAW * R_WSLOT, R_OB = R_OPS + 2 * R_SLOT, R_OBSZ = CH * R_STR;
static_assert(R_OB + 2 * R_OBSZ + 16 <= LDS_BYTES, "LDS");

DI void rec_prep(const LAS unsigned char* raw, LAS unsigned char* sl, int tg, int kp, int rg) {
    unsigned kw[8], qw[8], vw[8];
#pragma unroll
    for (int j = 0; j < 8; ++j) { const int ro = (8 * rg + j) * 64 + kp * 4; qw[j] = *(const LAS unsigned*)(raw + ro); kw[j] = *(const LAS unsigned*)(raw + 2048 + ro); vw[j] = *(const LAS unsigned*)(raw + 4096 + ro); }
    f32x2 P = {1.f, 1.f}, Pl[8];
#pragma unroll
    for (int j = 0; j < 8; ++j) { const f32x2 f = {1.0f - bf_lo(kw[j]), 1.0f - bf_hi(kw[j])}; P = P * f; Pl[j] = P; }
    f32x2 T[4];
#pragma unroll
    for (int g = 0; g < 4; ++g) { T[g].x = __shfl(P.x, 16 * g + kp); T[g].y = __shfl(P.y, 16 * g + kp); }
    const f32x2 one = {1.f, 1.f};
    f32x2 pre = rg >= 1 ? T[0] : one; pre = pre * (rg >= 2 ? T[1] : one); pre = pre * (rg >= 3 ? T[2] : one);
    const f32x2 PL = (T[0] * T[1]) * (T[2] * T[3]);
    f32x2 ke[8];
    const int cb = 64 * tg + 2 * (8 * ((kp >> 1) & 3) + 4 * (kp >> 3) + 2 * (kp & 1));
#pragma unroll
    for (int j = 0; j < 8; ++j) { const int t = 8 * rg + j; const f32x2 Pa = pre * Pl[j];
        const f32x2 ki = {bf_lo(kw[j]) * fast_rcp(Pa.x), bf_hi(kw[j]) * fast_rcp(Pa.y)}; ke[j] = ki * PL;
        *(LAS unsigned*)(sl + R_QD + t * R_STR + cb) = pk2(bf_lo(qw[j]) * Pa.x, bf_hi(qw[j]) * Pa.y);
        *(LAS unsigned*)(sl + R_KI + t * R_STR + cb) = pk2(ki.x, ki.y); }
    const int n0 = 32 * tg + 2 * kp, so = ((rg ^ (kp & 3)) * 16);
    u32x4 k0, k1, v0, v1;
    k0.x = pk2(ke[0].x, ke[1].x); k0.y = pk2(ke[2].x, ke[3].x); k0.z = pk2(ke[4].x, ke[5].x); k0.w = pk2(ke[6].x, ke[7].x);
    k1.x = pk2(ke[0].y, ke[1].y); k1.y = pk2(ke[2].y, ke[3].y); k1.z = pk2(ke[4].y, ke[5].y); k1.w = pk2(ke[6].y, ke[7].y);
    v0.x = (vw[0] & 0xffffu) | (vw[1] << 16); v0.y = (vw[2] & 0xffffu) | (vw[3] << 16); v0.z = (vw[4] & 0xffffu) | (vw[5] << 16); v0.w = (vw[6] & 0xffffu) | (vw[7] << 16);
    v1.x = (vw[0] >> 16) | (vw[1] & 0xffff0000u); v1.y = (vw[2] >> 16) | (vw[3] & 0xffff0000u); v1.z = (vw[4] >> 16) | (vw[5] & 0xffff0000u); v1.w = (vw[6] >> 16) | (vw[7] & 0xffff0000u);
    *(LAS u32x4*)(sl + R_KE + n0 * 64 + so) = k0; *(LAS u32x4*)(sl + R_KE + (n0 + 1) * 64 + so) = k1;
    *(LAS u32x4*)(sl + R_VT + n0 * 64 + so) = v0; *(LAS u32x4*)(sl + R_VT + (n0 + 1) * 64 + so) = v1;
    if (rg == 0) *(LAS f32x2*)(sl + R_DD + n0 * 4) = PL;
}

DI void phase_rec(const Params& p, LAS unsigned char* lds) {
    const int tid = threadIdx.x, lane = tid & 63, w = __builtin_amdgcn_readfirstlane(tid >> 6), c16 = lane & 15, kg = lane >> 4;
    const bool prep = w >= 4;
    const int tg = w & 3, kp = lane & 15, rg = lane >> 4, pt = tid & 255;
    unsigned char* ws = p.ws;
    for (int s = blockIdx.x; s < NB * 2 * NH; s += gridDim.x) {
        const int b = s >> 4, dh = s & 15, dir = dh >> 3, h = dh & 7;
        const size_t sbase = ((size_t)b * SEQ * DM + h * 128) * 2;
        const unsigned char* gq = ws + OFF_S0 + sbase;
        unsigned char* gk = ws + (dir ? OFF_S2 : OFF_S1) + sbase;
        const unsigned char* gv = ws + OFF_S3 + sbase;
#define REC_ROWB(c, t) ((size_t)(dir ? (SEQ - 1 - (CH * (c) + (t))) : (CH * (c) + (t))) * (DM * 2))
#define REC_DMA1(c, a_, half_) do { const unsigned char* _src = ((a_) == 0 ? gq : ((a_) == 1 ? (const unsigned char*)gk : gv)) + REC_ROWB(c, 16 * (half_) + (lane >> 2)) + 64 * tg + (lane & 3) * 16; \
        __builtin_amdgcn_global_load_lds((const unsigned*)_src, (LAS unsigned*)(lds + R_RAW + (tg * R_NRAW + ((c) % R_NRAW)) * R_WSLOT + (a_) * 2048 + (half_) * 1024), 16, 0, 0); } while (0)
#define REC_DMA(c) do { REC_DMA1(c, 0, 0); REC_DMA1(c, 0, 1); REC_DMA1(c, 1, 0); REC_DMA1(c, 1, 1); REC_DMA1(c, 2, 0); REC_DMA1(c, 2, 1); } while (0)
#define REC_RAWSLOT(c) (lds + R_RAW + (tg * R_NRAW + ((c) % R_NRAW)) * R_WSLOT)
#define REC_OUT(c) do { _Pragma("unroll") for (int _k = 0; _k < 2; ++_k) { const int _id = pt + 256 * _k, _t = _id >> 4, _pc = _id & 15; \
        const u32x4 _v = *(const LAS u32x4*)(lds + R_OB + ((c) & 1) * R_OBSZ + _t * R_STR + _pc * 16); *(u32x4*)(gk + REC_ROWB(c, _t) + _pc * 16) = _v; } } while (0)
        __syncthreads();
        if (prep) { REC_DMA(0); REC_DMA(1); REC_DMA(2); }
        asm volatile("s_waitcnt vmcnt(0)" ::: "memory"); __builtin_amdgcn_s_barrier(); asm volatile("" ::: "memory");
        if (prep) rec_prep(REC_RAWSLOT(0), lds + R_OPS, tg, kp, rg);
        asm volatile("s_waitcnt lgkmcnt(0)" ::: "memory"); __builtin_amdgcn_s_barrier(); asm volatile("" ::: "memory");
        const int sx = (c16 >> 1) & 3;
#define REC_STEP_BARRIER() do { asm volatile("s_waitcnt lgkmcnt(0)" ::: "memory"); __builtin_amdgcn_s_barrier(); asm volatile("" ::: "memory"); } while (0)
        if (prep) {
            for (int c = 0; c < NCH; ++c) {
                if (c + R_DIST < NCH) REC_DMA(c + R_DIST);
                if (c >= 3 && c + R_DIST < NCH) asm volatile("s_waitcnt vmcnt(16)" ::: "memory"); else asm volatile("s_waitcnt vmcnt(0)" ::: "memory");
                if (c + 1 < NCH) rec_prep(REC_RAWSLOT(c + 1), lds + R_OPS + ((c + 1) & 1) * R_SLOT, tg, kp, rg);
                if (c >= 1) REC_OUT(c - 1);
                REC_STEP_BARRIER();
            }
        } else {
            __builtin_amdgcn_s_setprio(2);
            f32x4 S[2][8];
#pragma unroll
            for (int d = 0; d < 2; ++d)
#pragma unroll
                for (int i = 0; i < 8; ++i) S[d][i] = (f32x4){0.f, 0.f, 0.f, 0.f};
            for (int c = 0; c < NCH; ++c) {
                const LAS unsigned char* sl = lds + R_OPS + (c & 1) * R_SLOT;
                bf16x8 qf[2][4], kf[2][4];
#pragma unroll
                for (int tt = 0; tt < 2; ++tt)
#pragma unroll
                    for (int pp = 0; pp < 4; ++pp) {
                        qf[tt][pp] = *(const LAS bf16x8*)(sl + R_QD + (16 * tt + c16) * R_STR + 64 * pp + 16 * kg);
                        kf[tt][pp] = *(const LAS bf16x8*)(sl + R_KI + (16 * tt + c16) * R_STR + 64 * pp + 16 * kg); }
#define REC_TFRAG(base, row) __builtin_shufflevector(*(const LAS bf16x4*)(sl + (base) + (row) * 64 + (((kg >> 1) ^ sx) * 16) + (kg & 1) * 8), \
                                                     *(const LAS bf16x4*)(sl + (base) + (row) * 64 + (((2 + (kg >> 1)) ^ sx) * 16) + (kg & 1) * 8), 0, 1, 2, 3, 4, 5, 6, 7)
                bf16x8 vf8[2];
#pragma unroll
                for (int d = 0; d < 2; ++d) vf8[d] = REC_TFRAG(R_VT, 32 * w + 16 * d + c16);
                f32x4 o2[2][2];
#pragma unroll
                for (int tt = 0; tt < 2; ++tt)
#pragma unroll
                    for (int d = 0; d < 2; ++d) o2[tt][d] = (f32x4){0.f, 0.f, 0.f, 0.f};
                f32x4 T00 = (f32x4){0.f, 0.f, 0.f, 0.f}, T01 = T00, T11 = T00;
#pragma unroll
                for (int pp = 0; pp < 4; ++pp) {
                    T00 = __builtin_amdgcn_mfma_f32_16x16x32_bf16(kf[0][pp], qf[0][pp], T00, 0, 0, 0);
                    T01 = __builtin_amdgcn_mfma_f32_16x16x32_bf16(kf[0][pp], qf[1][pp], T01, 0, 0, 0);
                    T11 = __builtin_amdgcn_mfma_f32_16x16x32_bf16(kf[1][pp], qf[1][pp], T11, 0, 0, 0);
#pragma unroll
                    for (int d = 0; d < 2; ++d) {
                        u32x4 sw; sw.x = pk2(S[d][2 * pp][0], S[d][2 * pp][1]); sw.y = pk2(S[d][2 * pp][2], S[d][2 * pp][3]); sw.z = pk2(S[d][2 * pp + 1][0], S[d][2 * pp + 1][1]); sw.w = pk2(S[d][2 * pp + 1][2], S[d][2 * pp + 1][3]);
                        const bf16x8 Sb = __builtin_bit_cast(bf16x8, sw);
                        o2[0][d] = __builtin_amdgcn_mfma_f32_16x16x32_bf16(qf[0][pp], Sb, o2[0][d], 0, 0, 0);
                        o2[1][d] = __builtin_amdgcn_mfma_f32_16x16x32_bf16(qf[1][pp], Sb, o2[1][d], 0, 0, 0); } }
#pragma unroll
                for (int i = 0; i < 8; ++i) {
                    const f32x4 dv4 = *(const LAS f32x4*)(sl + R_DD + (16 * i + 4 * kg) * 4);
                    const bf16x8 kef8 = REC_TFRAG(R_KE, 16 * i + c16);
#pragma unroll
                    for (int d = 0; d < 2; ++d) S[d][i] = __builtin_amdgcn_mfma_f32_16x16x32_bf16(kef8, vf8[d], S[d][i] * dv4, 0, 0, 0); }
#undef REC_TFRAG
#pragma unroll
                for (int r = 0; r < 4; ++r) if (4 * kg + r > c16) { T00[r] = 0.f; T11[r] = 0.f; }
                u32x4 a0, a1;
                a0.x = pk2(T00[0], T00[1]); a0.y = pk2(T00[2], T00[3]); a0.z = 0u; a0.w = 0u;
                a1.x = pk2(T01[0], T01[1]); a1.y = pk2(T01[2], T01[3]); a1.z = pk2(T11[0], T11[1]); a1.w = pk2(T11[2], T11[3]);
                const bf16x8 sA[2] = {__builtin_bit_cast(bf16x8, a0), __builtin_bit_cast(bf16x8, a1)};
                LAS unsigned char* ob = lds + R_OB + (c & 1) * R_OBSZ;
#pragma unroll
                for (int tt = 0; tt < 2; ++tt)
#pragma unroll
                    for (int d = 0; d < 2; ++d) {
                        const f32x4 o = __builtin_amdgcn_mfma_f32_16x16x32_bf16(sA[tt], vf8[d], o2[tt][d], 0, 0, 0);
#pragma unroll
                        for (int r = 0; r < 4; ++r) *(LAS bf16_t*)(ob + (16 * tt + 4 * kg + r) * R_STR + (32 * w + 16 * d + c16) * 2) = (bf16_t)(pk2(o[r], 0.f) & 0xffffu); }
                REC_STEP_BARRIER();
            }
            __builtin_amdgcn_s_setprio(0);
        }
#undef REC_STEP_BARRIER
        if (prep) REC_OUT(NCH - 1);
        asm volatile("s_waitcnt vmcnt(0) lgkmcnt(0)" ::: "memory"); __builtin_amdgcn_s_barrier(); asm volatile("" ::: "memory");
#undef REC_ROWB
#undef REC_DMA1
#undef REC_DMA
#undef REC_RAWSLOT
#undef REC_OUT
    }
}

DI void comb_one(const Params& p, int oi, const u32x4 a, const u32x4 bb, const u32x4 gg, const u32x4 (&pv)[17], u32x4* of, u32x4* yp) {
    const int co = oi & 127;
    float o[8];
    o[0] = bf_lo(a.x) + bf_lo(bb.x); o[1] = bf_hi(a.x) + bf_hi(bb.x); o[2] = bf_lo(a.y) + bf_lo(bb.y); o[3] = bf_hi(a.y) + bf_hi(bb.y);
    o[4] = bf_lo(a.z) + bf_lo(bb.z); o[5] = bf_hi(a.z) + bf_hi(bb.z); o[6] = bf_lo(a.w) + bf_lo(bb.w); o[7] = bf_hi(a.w) + bf_hi(bb.w);
    float s = 0.f;
#pragma unroll
    for (int j = 0; j < 8; ++j) s += o[j] * o[j];
    s += __shfl_xor(s, 1); s += __shfl_xor(s, 2); s += __shfl_xor(s, 4); s += __shfl_xor(s, 8);
    const float r = rsqrtf(s * (1.0f / 128.0f) + EPS);
    const f32x4 g0 = *(const f32x4*)(p.hgrn_g + co * 8), g1 = *(const f32x4*)(p.hgrn_g + co * 8 + 4);
    u32x4 y;
    y.x = pk2(o[0] * r * g0[0] * siluf_(bf_lo(gg.x)), o[1] * r * g0[1] * siluf_(bf_hi(gg.x))); y.y = pk2(o[2] * r * g0[2] * siluf_(bf_lo(gg.y)), o[3] * r * g0[3] * siluf_(bf_hi(gg.y)));
    y.z = pk2(o[4] * r * g1[0] * siluf_(bf_lo(gg.z)), o[5] * r * g1[1] * siluf_(bf_hi(gg.z))); y.w = pk2(o[6] * r * g1[2] * siluf_(bf_lo(gg.w)), o[7] * r * g1[3] * siluf_(bf_hi(gg.w)));
    of[oi] = y;
    const int row = oi >> 7, t = row & (SEQ - 1), half = 1 << (co >> 5);
    const int lo = max(t - half + 1, 0), hi = min(t + half + 1, SEQ);
    float acc[8];
#pragma unroll
    for (int j = 0; j < 8; ++j) acc[j] = 0.f;
#pragma unroll
    for (int j = 0; j < 16; ++j) { const u32x4 v = pv[1 + j];
        acc[0] += bf_lo(v.x); acc[1] += bf_hi(v.x); acc[2] += bf_lo(v.y); acc[3] += bf_hi(v.y); acc[4] += bf_lo(v.z); acc[5] += bf_hi(v.z); acc[6] += bf_lo(v.w); acc[7] += bf_hi(v.w); }
    const float ic = 1.0f / (float)(hi - lo);
    const u32x4 c = pv[0];
    u32x4 q;
    q.x = pk2(acc[0] * ic - bf_lo(c.x), acc[1] * ic - bf_hi(c.x)); q.y = pk2(acc[2] * ic - bf_lo(c.y), acc[3] * ic - bf_hi(c.y));
    q.z = pk2(acc[4] * ic - bf_lo(c.z), acc[5] * ic - bf_hi(c.z)); q.w = pk2(acc[6] * ic - bf_lo(c.w), acc[7] * ic - bf_hi(c.w));
    yp[oi] = q;
}
DI void phase_comb(const Params& p) {
    unsigned char* ws = p.ws;
    const int gt = blockIdx.x * 512 + threadIdx.x, NT = gridDim.x * 512;
    u32x4* of = (u32x4*)(ws + OFF_S1); const u32x4* ob = (const u32x4*)(ws + OFF_S2); const u32x4* og = (const u32x4*)(ws + OFF_S4);
    const u32x4* pin = (const u32x4*)(ws + OFF_S5); u32x4* yp = (u32x4*)(ws + OFF_XB);
    const u32x4 zero = {0u, 0u, 0u, 0u};
    for (int oi = gt; oi < MTOK * 128; oi += NT) {
        const int co = oi & 127, row = oi >> 7, t = row & (SEQ - 1), half = 1 << (co >> 5);
        const int lo = max(t - half + 1, 0), hi = min(t + half + 1, SEQ);
        const u32x4 a = of[oi], bb = ob[oi], gg = og[oi];
        u32x4 pv[17];
        pv[0] = pin[oi];
#pragma unroll
        for (int j = 0; j < 16; ++j) { const int tt = lo + j; pv[1 + j] = (tt < hi) ? pin[oi + (tt - t) * 128] : zero; }
        comb_one(p, oi, a, bb, gg, pv, of, yp);
    }
}

DI void phase_final(const Params& p) {
    const float* ssq = (const float*)(p.ws + OFF_SSQ3);
    const u32x4* hb = (const u32x4*)(p.ws + OFF_S2);
    f32x4* o = (f32x4*)p.out;
    const int gt = blockIdx.x * 512 + threadIdx.x, NT = gridDim.x * 512;
    const f32x4 g0 = *((const f32x4*)p.g_final + 2 * (gt & 127)), g1 = *((const f32x4*)p.g_final + 2 * (gt & 127) + 1);
    for (int i0 = gt; i0 < MTOK * DM / 8; i0 += 8 * NT) {
        u32x4 v[8]; float r[8];
#pragma unroll
        for (int k = 0; k < 8; ++k) { const int i = i0 + k * NT; v[k] = hb[i]; r[k] = ssq[i >> 7]; }
#pragma unroll
        for (int k = 0; k < 8; ++k) { const int i = i0 + k * NT; const float rr = rsqrtf(r[k] * (1.0f / DM) + EPS);
            const f32x4 a = {bf_lo(v[k].x), bf_hi(v[k].x), bf_lo(v[k].y), bf_hi(v[k].y)}, bq = {bf_lo(v[k].z), bf_hi(v[k].z), bf_lo(v[k].w), bf_hi(v[k].w)};
            o[2 * i] = a * rr * g0; o[2 * i + 1] = bq * rr * g1; }
    }
}

#ifndef DBG_STOP
#define DBG_STOP -1
#endif
DI void phase_digest(const Params& p) {
    const unsigned short* b0 = (const unsigned short*)(p.ws + OFF_XB);
    const int gt = blockIdx.x * 512 + threadIdx.x, NT = gridDim.x * 512;
    for (int i = gt; i < MTOK * DM / 2; i += NT) {
        unsigned acc = 0;
#pragma unroll
        for (int j = 0; j < 7; ++j) acc += (unsigned)b0[(size_t)j * (SPL / 2) + i] + 3u * (unsigned)b0[(size_t)j * (SPL / 2) + i + MTOK * DM / 2];
        if (DBG_STOP < 4) { const unsigned short* g = (const unsigned short*)p.out; acc += (unsigned)g[2 * (size_t)i] + 5u * (unsigned)g[2 * (size_t)i + 1] + 7u * (unsigned)g[(size_t)MTOK * DM + i] ; }
        p.out[i] = (float)(acc & 0xfffffu);
    }
}

#define XB_TMO      128
#define XB_XCNT(j)  (256  + 64 * (j))
#define XB_XSUB(j)  (1280 + 64 * (j))
#define XB_XGEN(j)  (2304 + 64 * (j))
#define XB_TOP      3328
#define XB_TOPGEN   3392
#define XCD_BAR_WORDS 3456
#define XB_SPIN_CAP (1u << 18)

__device__ __forceinline__ unsigned xb_ld(unsigned* p)              { return __hip_atomic_load(p, __ATOMIC_RELAXED, __HIP_MEMORY_SCOPE_AGENT); }
__device__ __forceinline__ unsigned xb_add(unsigned* p, unsigned v) { return __hip_atomic_fetch_add(p, v, __ATOMIC_RELAXED, __HIP_MEMORY_SCOPE_AGENT); }
__device__ __forceinline__ unsigned xb_xcc_id() { return (unsigned)__builtin_amdgcn_s_getreg((3 << 11) | 20) & 0xFu; }
#define XB_SPIN(cond, bar) do { unsigned _sp = 0; while (cond) { __builtin_amdgcn_s_sleep(1); \
    if ((++_sp & 255u) == 0u) { if (xb_ld(&(bar)[XB_TMO])) break; if (_sp > XB_SPIN_CAP) { atomicAdd(&(bar)[XB_TMO], 1u); break; } } } } while (0)

struct XcdBarrier {
    unsigned* bar; unsigned x;
    volatile LAS unsigned* st;
};

__device__ __forceinline__ XcdBarrier xcd_barrier_post(unsigned* bar, volatile LAS unsigned* st) {
    XcdBarrier b; b.bar = bar; b.x = xb_xcc_id(); b.st = st;
    if (threadIdx.x == 0) (void)xb_add(&bar[XB_XCNT(b.x)], 1u);
    return b;
}
__device__ __forceinline__ void xcd_barrier_complete(unsigned* bar, unsigned x, unsigned& nloc, unsigned& nx) {
    const unsigned G = gridDim.x * gridDim.y * gridDim.z;
    unsigned sum, cnt, mine, sp = 0u;
    for (;;) {
        sum = 0u; cnt = 0u; mine = 0u;
#pragma unroll
        for (unsigned j = 0; j < 16; ++j) { const unsigned c = xb_ld(&bar[XB_XCNT(j)]); sum += c; cnt += (c > 0u) ? 1u : 0u; mine = (j == x) ? c : mine; }
        if (sum == G) break;
        __builtin_amdgcn_s_sleep(1);
        if ((++sp & 255u) == 0u) { if (xb_ld(&bar[XB_TMO])) break; if (sp > XB_SPIN_CAP) { atomicAdd(&bar[XB_TMO], 1u); break; } }
    }
    nloc = mine > 0u ? mine : 1u; nx = cnt > 0u ? cnt : 1u;
}

__device__ __forceinline__ void xcd_barrier(const XcdBarrier& b) {
    asm volatile("s_waitcnt vmcnt(0)" ::: "memory");
    __syncthreads();
    if (threadIdx.x == 0) {
        unsigned* bar = b.bar;
        __builtin_amdgcn_s_waitcnt(0);
        unsigned nloc = b.st[0], nx = b.st[1];
        if (nloc == 0u) { xcd_barrier_complete(bar, b.x, nloc, nx); b.st[0] = nloc; b.st[1] = nx; }
        const unsigned old = xb_add(&bar[XB_XSUB(b.x)], 1u);
        const unsigned gen = old / nloc;
        if (old + 1u == (gen + 1u) * nloc) {
            __builtin_amdgcn_fence(__ATOMIC_RELEASE, "agent");
            asm volatile("s_waitcnt vmcnt(0)" ::: "memory");
            const unsigned og = xb_add(&bar[XB_TOP], 1u);
            const unsigned tg = og / nx;
            if (og + 1u == (tg + 1u) * nx) xb_add(&bar[XB_TOPGEN], 1u);
            else XB_SPIN(xb_ld(&bar[XB_TOPGEN]) == tg, bar);
            __builtin_amdgcn_fence(__ATOMIC_ACQUIRE, "agent");
            xb_add(&bar[XB_XGEN(b.x)], 1u);
            asm volatile("s_waitcnt vmcnt(0)" ::: "memory");
        } else {
            XB_SPIN(xb_ld(&bar[XB_XGEN(b.x)]) == gen, bar);
            __builtin_amdgcn_fence(__ATOMIC_ACQUIRE, "agent");
            asm volatile("s_waitcnt vmcnt(0)" ::: "memory");
        }
    }
    __syncthreads();
}


#ifndef WGM_WIDE
#define WGM_WIDE 7
#define WGM_NARROW 8
#endif
__global__ void __launch_bounds__(512, 2) fwd_kernel(Params p, int ph_lo, int ph_hi) {
    extern __shared__ __attribute__((aligned(16))) unsigned char lds_raw[];
    LAS unsigned char* lds = (LAS unsigned char*)lds_raw;
    cg::grid_group grid = cg::this_grid();
    unsigned char* ws = p.ws;
    const int G = gridDim.x, c = blockIdx.x;
#define IN(k) (ph_lo <= (k) && (k) < ph_hi)
    volatile LAS unsigned* xst = (volatile LAS unsigned*)(lds + LDS_BYTES - 16);
    if (threadIdx.x < 4) xst[threadIdx.x] = 0u;
    __syncthreads();
    const XcdBarrier xbar = xcd_barrier_post((unsigned*)(ws + OFF_BAR), xst);
    if (ph_lo < 0) grid.sync();
#define SEAM(k) do { if (IN(k) && IN((k) + 1)) xcd_barrier(xbar); } while (0)
    if (IN(0)) phase0(p, lds);
    SEAM(0);
    if (IN(1)) {
        pg8::Gemm g{(const bf16_t*)(ws + OFF_XB), (const bf16_t*)(ws + OFF_XB), (const bf16_t*)(ws + OFF_WIN), DM, 1 << 30};
        pg8::StaticOrder S; S.init(MTOK, 8192, G, c, WGM_WIDE);
        pg8::EpiProj E{ws, p.out, (const float*)(ws + OFF_OML)};
        pg8::gemm_phase(lds, g, S, E);
    }
    SEAM(1);
    if (IN(2)) phase_rec(p, lds);
    SEAM(2);
    if (IN(3)) phase_comb(p);
    SEAM(3);
    if (IN(4)) {
        pg8::Gemm g{(const bf16_t*)(ws + OFF_S1), (const bf16_t*)(ws + OFF_XB), (const bf16_t*)(ws + OFF_WAB), DM, 4};
        pg8::PairOrder S; S.so.init(MTOK, DM, G, c, WGM_NARROW);
        pg8::EpiMerge E{(const bf16_t*)p.out, (bf16_t*)(ws + OFF_S0)};
        pg8::gemm_phase(lds, g, S, E);
    }
    SEAM(4);
    if (IN(5)) {
        pg8::Gemm g{(const bf16_t*)(ws + OFF_S0), (const bf16_t*)(ws + OFF_S0), (const bf16_t*)(ws + OFF_WO), DM, 1 << 30};
        pg8::StaticOrder S; S.init(MTOK, DM, G, c, WGM_NARROW);
        pg8::EpiResid<true, false, false> E{p.x, nullptr, (bf16_t*)(ws + OFF_S4), (float*)(ws + OFF_SSQ2)};
        pg8::gemm_phase(lds, g, S, E);
    }
    SEAM(5);
    if (IN(6)) {
        pg8::Gemm g{(const bf16_t*)(ws + OFF_S4), (const bf16_t*)(ws + OFF_S4), (const bf16_t*)(ws + OFF_WFI), DM, 1 << 30};
        pg8::StaticOrder S; S.init(MTOK, 2 * FF, G, c, WGM_WIDE);
        pg8::EpiSwiglu E{(const float*)(ws + OFF_SSQ2), (bf16_t*)(ws + OFF_ACT)};
        pg8::gemm_phase(lds, g, S, E);
    }
    SEAM(6);
    if (IN(7)) {
        pg8::Gemm g{(const bf16_t*)(ws + OFF_ACT), (const bf16_t*)(ws + OFF_ACT), (const bf16_t*)(ws + OFF_WFO), FF, 1 << 30};
        pg8::StaticOrder S; S.init(MTOK, DM, G, c, WGM_NARROW);
        pg8::EpiResid<true, false, true> E{(const bf16_t*)(ws + OFF_S4), nullptr, (bf16_t*)(ws + OFF_S2), (float*)(ws + OFF_SSQ3)};
        pg8::gemm_phase(lds, g, S, E);
    }
    SEAM(7);
    if (IN(8)) phase_final(p);
    if (IN(9)) phase_digest(p);
#undef IN
#undef SEAM
}

#ifndef N_LAUNCHES
#define N_LAUNCHES 1
#endif

extern "C" void kernel_launch(void* const* d_in, const int* in_sizes, int n_in, void* d_out, int out_size, void* d_ws, size_t ws_size, hipStream_t stream) {
    static int grid = 0;
    if (grid == 0) {
        if (n_in != 14 || in_sizes[0] != MTOK * DM || out_size != MTOK * DM || ws_size < WS_END) {
            fprintf(stderr, "kernel_launch: unexpected shapes (n_in %d, in0 %d, out %d, ws %zu, need %zu)\n", n_in, n_in > 0 ? in_sizes[0] : -1, out_size, ws_size, (size_t)WS_END); grid = -1; return; }
        int dev = 0, cus = 0, per_cu = 0;
        hipGetDevice(&dev);
        hipDeviceGetAttribute(&cus, hipDeviceAttributeMultiprocessorCount, dev);
        if (hipFuncSetAttribute((const void*)fwd_kernel, hipFuncAttributeMaxDynamicSharedMemorySize, LDS_BYTES) != hipSuccess) { fprintf(stderr, "kernel_launch: hipFuncSetAttribute failed\n"); grid = -1; return; }
        if (hipOccupancyMaxActiveBlocksPerMultiprocessor(&per_cu, (const void*)fwd_kernel, 512, LDS_BYTES) != hipSuccess || per_cu < 1) { fprintf(stderr, "kernel_launch: occupancy query failed (%d)\n", per_cu); (void)hipGetLastError(); per_cu = 1; }
        grid = cus * 1;
        if (grid > 256) grid = 256;
    }
    if (grid < 0) return;
    Params p{};
    p.x = (const float*)d_in[0]; p.g_mix = (const float*)d_in[1]; p.w_in = (const float*)d_in[2]; p.lb_logits = (const float*)d_in[3];
    p.hgrn_g = (const float*)d_in[4]; p.pool_w = (const float*)d_in[5]; p.pool_scale = (const float*)d_in[6]; p.w_a = (const float*)d_in[7];
    p.w_b = (const float*)d_in[8]; p.w_out = (const float*)d_in[9]; p.g_ffn = (const float*)d_in[10]; p.w_fi = (const float*)d_in[11];
    p.w_fo = (const float*)d_in[12]; p.g_final = (const float*)d_in[13];
    p.out = (float*)d_out; p.ws = (unsigned char*)d_ws;
    if (hipMemsetAsync((unsigned char*)d_ws + OFF_BAR, 0, XCD_BAR_WORDS * 4, stream) != hipSuccess) { fprintf(stderr, "kernel_launch: memset of the barrier words failed\n"); return; }
#if N_LAUNCHES == 1
    int lo = 0, hi = 9;
    void* args[] = {&p, &lo, &hi};
    hipError_t e = hipLaunchCooperativeKernel((const void*)fwd_kernel, dim3(grid), dim3(512), args, LDS_BYTES, stream);
    if (e != hipSuccess) fprintf(stderr, "kernel_launch: cooperative launch failed: %s (grid %d)\n", hipGetErrorString(e), grid);
#else
    for (int ph = 0; ph < (DBG_STOP >= 0 ? DBG_STOP + 2 : 9); ++ph) {
        int lo = ph, hi = ph + 1;
        if (DBG_STOP >= 0 && ph == DBG_STOP + 1) { lo = 9; hi = 10; }
        void* args[] = {&p, &lo, &hi};
        hipError_t e = hipLaunchCooperativeKernel((const void*)fwd_kernel, dim3(grid), dim3(512), args, LDS_BYTES, stream);
        if (e != hipSuccess) fprintf(stderr, "kernel_launch: launch %d failed: %s (grid %d)\n", ph, hipGetErrorString(e), grid);
    }
#endif
}
```

```cpp
#include <hip/hip_runtime.h>
#include <hip/hip_cooperative_groups.h>
#include <cstdio>
#include <cstdint>
namespace cg = cooperative_groups;

#define LAS __attribute__((address_space(3)))
#define DI __device__ __forceinline__
typedef unsigned short bf16_t;
typedef short bf16x8 __attribute__((ext_vector_type(8)));
typedef short bf16x4 __attribute__((ext_vector_type(4)));
typedef float f32x4 __attribute__((ext_vector_type(4)));
typedef float f32x2 __attribute__((ext_vector_type(2)));
typedef unsigned u32x4 __attribute__((ext_vector_type(4)));
typedef unsigned u32x2 __attribute__((ext_vector_type(2)));

constexpr int MTOK = 32768, DM = 1024, SEQ = 2048, NB = 16, NH = 8, FF = 2816;
constexpr float EPS = 1e-6f;
constexpr size_t MiB = (size_t)1 << 20;
constexpr size_t OFF_WIN = 0;
constexpr size_t OFF_WAB = 16 * MiB;
constexpr size_t OFF_WO = 20 * MiB;
constexpr size_t OFF_WFI = 22 * MiB;
constexpr size_t OFF_WFO = 33 * MiB;
constexpr size_t OFF_SSQ2 = 39 * MiB;
constexpr size_t OFF_SSQ3 = OFF_SSQ2 + 131072;
constexpr size_t OFF_OML = OFF_SSQ3 + 131072;
constexpr size_t OFF_BAR = 40 * MiB;
constexpr size_t OFF_XB = 41 * MiB;
constexpr size_t OFF_S0 = 105 * MiB;
constexpr size_t SPL = 64 * MiB;
constexpr size_t OFF_S1 = OFF_S0 + SPL;
constexpr size_t OFF_S2 = OFF_S1 + SPL;
constexpr size_t OFF_S3 = OFF_S2 + SPL;
constexpr size_t OFF_S4 = OFF_S3 + SPL;
constexpr size_t OFF_S5 = OFF_S4 + SPL;
constexpr size_t OFF_ACT = OFF_XB;
constexpr size_t WS_END = OFF_S5 + SPL;
constexpr int LDS_BYTES = 163840;

struct Params {
    const float *x, *g_mix, *w_in, *lb_logits, *hgrn_g, *pool_w, *pool_scale, *w_a, *w_b, *w_out, *g_ffn, *w_fi, *w_fo, *g_final;
    float* out; unsigned char* ws;
};

DI unsigned pk2(float lo, float hi) {
    typedef __bf16 bf2 __attribute__((ext_vector_type(2)));
    f32x2 v = {lo, hi};
    bf2 b = __builtin_convertvector(v, bf2);
    return __builtin_bit_cast(unsigned, b);
}
DI float bf_lo(unsigned u) { return __uint_as_float(u << 16); }
DI float bf_hi(unsigned u) { return __uint_as_float(u & 0xffff0000u); }
DI float bf2f(bf16_t h) { return __uint_as_float(((unsigned)h) << 16); }
DI float fast_rcp(float x) { return __builtin_amdgcn_rcpf(x); }
DI float sigmoidf_(float v) { return fast_rcp(1.0f + __expf(-v)); }
DI float siluf_(float v) { return v * fast_rcp(1.0f + __expf(-v)); }
DI float wave_sum(float v) {
#pragma unroll
    for (int o = 1; o < 64; o <<= 1) v += __shfl_xor(v, o);
    return v;
}
#define LDS_WAIT() asm volatile("s_waitcnt lgkmcnt(0)" ::: "memory")

namespace pg8 {
constexpr int BM = 256, BK = 64, HALF = 128, HTB = HALF * BK * 2, STAGE_BYTES = 8 * HTB, NXCD = 8;
DI int lds_byte(int r, int c) { const int st = (r >> 4) * 2 + (c >> 5), rr = r & 15, cc = c & 31, ob = rr * 64 + cc * 2; return st * 1024 + (ob ^ (((ob >> 9) & 1) << 5)); }
DI void stage_rc(int b, int& R, int& C) { const int st = b / 1024, sb = b % 1024, swz = sb ^ (((sb >> 9) & 1) << 5); R = (st >> 1) * 16 + swz / 64; C = (st & 1) * 32 + (swz % 64) / 2; }
DI int perm32(int rho) { const int n = rho >> 4, i = rho & 15; return 8 * (i >> 2) + 4 * n + (i & 3); }

struct Unit { int pm, pn; };
struct Gemm { const bf16_t* A; const bf16_t* A2; const bf16_t* Bt; int K; int nsplit; };

struct StaticOrder {
    int nM, nN, nwg, G, c, WGM;
    DI void init(int M, int N, int G_, int c_, int wgm = 4) { nM = M / BM; nN = N / BM; nwg = nM * nN; G = G_; c = c_; WGM = wgm; }
    DI bool next(int i, Unit& u) const {
        const long L = (long)i * G + c; if (L >= nwg) return false;
        int wgid = (int)L; { const int q = nwg / NXCD, r = nwg % NXCD, xcd = wgid % NXCD, off = wgid / NXCD; wgid = (xcd < r ? xcd * (q + 1) : r * (q + 1) + (xcd - r) * q) + off; }
        const int nig = WGM * nN, gid = wgid / nig, fm = gid * WGM, gsz = (nM - fm) < WGM ? (nM - fm) : WGM;
        u.pm = fm + ((wgid % nig) % gsz); u.pn = (wgid % nig) / gsz; return true;
    }
};
struct PairOrder {
    StaticOrder so;
    DI bool next(int i, Unit& u) const { Unit t; if (!so.next(i >> 1, t)) return false; u.pm = t.pm; u.pn = t.pn + 4 * (i & 1); return true; }
};

template <class Epi, class Sched>
DI void gemm_phase(LAS unsigned char* lds, const Gemm g, const Sched& S, const Epi& E) {
    const int tid = threadIdx.x, wid = __builtin_amdgcn_readfirstlane(tid >> 6), lane = tid & 63, wr = wid >> 2, wc = wid & 3, fr = lane & 15, fq = lane >> 4;
    const int K = g.K, nt = K / BK;
    unsigned voffA[2], voffB[2];
#pragma unroll
    for (int i = 0; i < 2; ++i) { int R, C; stage_rc(tid * 16 + i * 8192, R, C); const int Rb = ((R & ~31) + perm32(R & 31));
        voffA[i] = (unsigned)(R * K + C) * 2u; voffB[i] = (unsigned)(Rb * K + C) * 2u; }
    const size_t kstep = (size_t)(BK * 2);
    const size_t hstep = (size_t)HALF * K * 2;
    const size_t tstep = 2 * hstep;
    const unsigned ldsw = (unsigned)wid * 1024u;
    const int aoff = lds_byte(wr * 64 + fr, fq * 8), boff = lds_byte(wc * 32 + fr, fq * 8);
#define PG8_SA(b, h) (((b) * 2 + (h)) * HTB)
#define PG8_SB(b, h) ((4 + (b) * 2 + (h)) * HTB)
#define PG8_STAGE(bufoff, gbase, voff) do { _Pragma("unroll") for (int _i = 0; _i < 2; ++_i) \
        __builtin_amdgcn_global_load_lds((const unsigned*)((const char*)(gbase) + (voff)[_i]), (LAS unsigned*)(lds + (bufoff) + ldsw + _i * 8192), 16, 0, 0); } while (0)
#define PG8_LDA(dst, b, h) do { _Pragma("unroll") for (int m = 0; m < 4; ++m) _Pragma("unroll") for (int k = 0; k < 2; ++k) dst[m][k] = *(const LAS bf16x8*)(lds + PG8_SA(b, h) + aoff + m * 2048 + k * 1024); } while (0)
#define PG8_LDB(dst, b, h) do { _Pragma("unroll") for (int n = 0; n < 2; ++n) _Pragma("unroll") for (int k = 0; k < 2; ++k) dst[n][k] = *(const LAS bf16x8*)(lds + PG8_SB(b, h) + boff + n * 2048 + k * 1024); } while (0)
#define PG8_MMA(ai, bj, At, Bt) do { __builtin_amdgcn_s_setprio(1); _Pragma("unroll") for (int m = 0; m < 4; ++m) _Pragma("unroll") for (int n = 0; n < 2; ++n) _Pragma("unroll") for (int k = 0; k < 2; ++k) \
        acc[ai][bj][m][n] = __builtin_amdgcn_mfma_f32_16x16x32_bf16(Bt[n][k], At[m][k], acc[ai][bj][m][n], 0, 0, 0); __builtin_amdgcn_s_setprio(0); } while (0)
#define PG8_WAIT_V(n) asm volatile("s_waitcnt vmcnt(" #n ")" ::: "memory")
#define PG8_WAIT_L(n) asm volatile("s_waitcnt lgkmcnt(" #n ")" ::: "memory")
#define PG8_BAR __builtin_amdgcn_s_barrier()
#define PG8_SCHED __builtin_amdgcn_sched_barrier(0)
#define PG8_ABASE(u) ((const char*)((u).pn >= g.nsplit ? g.A2 : g.A) + (size_t)(u).pm * tstep)
    Unit cur, nxt; int ui = 0;
    if (!S.next(0, cur)) return;
    f32x4 acc[2][2][4][2];
#pragma unroll
    for (int a = 0; a < 2; ++a)
#pragma unroll
        for (int b = 0; b < 2; ++b)
#pragma unroll
            for (int m = 0; m < 4; ++m)
#pragma unroll
                for (int n = 0; n < 2; ++n) acc[a][b][m][n] = (f32x4){0.f, 0.f, 0.f, 0.f};
    bf16x8 At[4][2], B0[2][2], B1[2][2];
    const char* cA = PG8_ABASE(cur); const char* cB = (const char*)g.Bt + (size_t)cur.pn * tstep;
    PG8_STAGE(PG8_SB(0, 0), cB, voffB); PG8_STAGE(PG8_SB(0, 1), cB + hstep, voffB); PG8_STAGE(PG8_SA(0, 0), cA, voffA); PG8_STAGE(PG8_SA(0, 1), cA + hstep, voffA);
    if (wr == 1) PG8_BAR;
    PG8_WAIT_V(2); PG8_BAR;
    PG8_STAGE(PG8_SB(1, 0), cB + kstep, voffB); PG8_STAGE(PG8_SA(1, 0), cA + kstep, voffA); PG8_STAGE(PG8_SB(1, 1), cB + hstep + kstep, voffB);
    PG8_WAIT_V(6); PG8_BAR;
    for (;;) {
        const bool has_next = S.next(ui + 1, nxt);
        const char* nA = has_next ? PG8_ABASE(nxt) : cA; const char* nB = has_next ? (const char*)g.Bt + (size_t)nxt.pn * tstep : cB;
        for (int t = 0; t < nt; t += 2) {
            const bool last = (t == nt - 2);
            const char* a1 = cA + (size_t)(t + 1) * kstep;
            const char* a2 = last ? nA : cA + (size_t)(t + 2) * kstep; const char* b2 = last ? nB : cB + (size_t)(t + 2) * kstep;
            const char* a3 = a2 + kstep; const char* b3 = b2 + kstep;
            PG8_LDB(B0, 0, 0); PG8_LDB(B1, 0, 1); PG8_SCHED; PG8_LDA(At, 0, 0); PG8_STAGE(PG8_SA(1, 1), a1 + hstep, voffA);
            PG8_WAIT_V(8); PG8_WAIT_L(0); PG8_BAR; PG8_MMA(0, 0, At, B0); PG8_MMA(0, 1, At, B1); PG8_BAR; PG8_SCHED;
            PG8_LDA(At, 0, 1); PG8_STAGE(PG8_SB(0, 0), b2, voffB); PG8_STAGE(PG8_SB(0, 1), b2 + hstep, voffB); PG8_STAGE(PG8_SA(0, 0), a2, voffA);
            PG8_WAIT_V(8); PG8_WAIT_L(0); PG8_BAR; PG8_MMA(1, 0, At, B0); PG8_MMA(1, 1, At, B1); PG8_BAR; PG8_SCHED;
            PG8_LDB(B0, 1, 0); PG8_LDB(B1, 1, 1); PG8_SCHED; PG8_LDA(At, 1, 0); PG8_STAGE(PG8_SA(0, 1), a2 + hstep, voffA);
            PG8_WAIT_V(8); PG8_WAIT_L(0); PG8_BAR; PG8_MMA(0, 0, At, B0); PG8_MMA(0, 1, At, B1); PG8_BAR; PG8_SCHED;
            PG8_LDA(At, 1, 1); PG8_STAGE(PG8_SB(1, 0), b3, voffB); PG8_STAGE(PG8_SB(1, 1), b3 + hstep, voffB); PG8_STAGE(PG8_SA(1, 0), a3, voffA);
            PG8_WAIT_V(8); PG8_WAIT_L(0); PG8_BAR; PG8_MMA(1, 0, At, B0); PG8_MMA(1, 1, At, B1); PG8_BAR; PG8_SCHED;
        }
        if (wr == 0) PG8_BAR;
        const bool keep = E(acc, cur, wr, wc, fr, fq);
        if (!has_next) break;
        if (!keep) {
#pragma unroll
        for (int a = 0; a < 2; ++a)
#pragma unroll
            for (int b = 0; b < 2; ++b)
#pragma unroll
                for (int m = 0; m < 4; ++m)
#pragma unroll
                    for (int n = 0; n < 2; ++n) acc[a][b][m][n] = (f32x4){0.f, 0.f, 0.f, 0.f};
        }
        cur = nxt; cA = nA; cB = nB; ++ui;
        if (wr == 1) PG8_BAR;
    }
    PG8_WAIT_V(0);
    PG8_BAR;
#undef PG8_SA
#undef PG8_SB
#undef PG8_STAGE
#undef PG8_LDA
#undef PG8_LDB
#undef PG8_MMA
#undef PG8_WAIT_V
#undef PG8_WAIT_L
#undef PG8_BAR
#undef PG8_SCHED
#undef PG8_ABASE
}

typedef f32x4 Acc[2][2][4][2];

struct EpiProj {
    unsigned char* ws; float* dout; const float* oml;
    template <int MODE> DI void run(const Acc& acc, bf16_t* base, const float* omlp, int row0, int col0) const {
        f32x4 ov[2][2];
#pragma unroll
        for (int bj = 0; bj < 2; ++bj)
#pragma unroll
            for (int n = 0; n < 2; ++n) ov[bj][n] = (MODE == 3) ? *(const f32x4*)(omlp + col0 + bj * HALF + 4 * n) : (f32x4){0.f, 0.f, 0.f, 0.f};
#pragma unroll
        for (int ai = 0; ai < 2; ++ai)
#pragma unroll
            for (int m = 0; m < 4; ++m) { bf16_t* rowp = base + (size_t)(row0 + ai * HALF + m * 16) * DM + col0;
#pragma unroll
                for (int bj = 0; bj < 2; ++bj) { f32x4 v[2] = {acc[ai][bj][m][0], acc[ai][bj][m][1]};
#pragma unroll
                    for (int n = 0; n < 2; ++n)
#pragma unroll
                        for (int j = 0; j < 4; ++j) { const float t = v[n][j];
                            if (MODE == 1) v[n][j] = siluf_(t);
                            if (MODE == 2) v[n][j] = sigmoidf_(t);
                            if (MODE == 3) v[n][j] = ov[bj][n][j] * fast_rcp(1.0f + __expf(t)); }
                    u32x4 w; w.x = pk2(v[0][0], v[0][1]); w.y = pk2(v[0][2], v[0][3]); w.z = pk2(v[1][0], v[1][1]); w.w = pk2(v[1][2], v[1][3]);
                    *(u32x4*)(rowp + bj * HALF) = w; } }
    }
    DI bool operator()(Acc& acc, const Unit& u, int wr, int wc, int fr, int fq) const {
        const int split = u.pn >> 2, colt = (u.pn & 3) * BM;
        bf16_t* base = split < 6 ? (bf16_t*)(ws + OFF_S0 + (size_t)split * SPL) : (bf16_t*)((unsigned char*)dout + (size_t)(split - 6) * SPL);
        const int row0 = u.pm * BM + wr * 64 + fr, col0 = colt + wc * 32 + 8 * fq;
        if (split == 0) run<1>(acc, base, oml, row0, col0);
        else if (split == 1) run<3>(acc, base, oml, row0, col0);
        else if (split == 2) run<3>(acc, base, oml + DM, row0, col0);
        else if (split == 3 || split == 4 || split == 5) run<0>(acc, base, oml, row0, col0);
        else run<2>(acc, base, oml, row0, col0);
        return false;
    }
};

struct EpiMerge {
    const bf16_t* gates;
    bf16_t* merged;
    DI bool operator()(Acc& acc, const Unit& u, int wr, int wc, int fr, int fq) const {
        const int sel = u.pn >> 2, colt = (u.pn & 3) * BM;
        const bf16_t* ga = gates; const bf16_t* gb = gates + (size_t)MTOK * DM;
        const int row0 = u.pm * BM + wr * 64 + fr, col0 = colt + wc * 32 + 8 * fq;
#pragma unroll
        for (int ai = 0; ai < 2; ++ai) {
            u32x4 bw[4][2], aw[4][2];
#pragma unroll
            for (int m = 0; m < 4; ++m)
#pragma unroll
                for (int bj = 0; bj < 2; ++bj) { const size_t off = (size_t)(row0 + ai * HALF + m * 16) * DM + col0 + bj * HALF;
                    bw[m][bj] = *(const u32x4*)(gb + off); aw[m][bj] = (sel == 0) ? *(const u32x4*)(ga + off) : (u32x4){0u, 0u, 0u, 0u}; }
            asm volatile("" ::: "memory");
#pragma unroll
            for (int m = 0; m < 4; ++m)
#pragma unroll
                for (int bj = 0; bj < 2; ++bj) { const size_t off = (size_t)(row0 + ai * HALF + m * 16) * DM + col0 + bj * HALF;
                    const u32x4 b4 = bw[m][bj];
                    float sb[8] = {bf_lo(b4.x), bf_hi(b4.x), bf_lo(b4.y), bf_hi(b4.y), bf_lo(b4.z), bf_hi(b4.z), bf_lo(b4.w), bf_hi(b4.w)};
#pragma unroll
                    for (int j = 0; j < 8; ++j) sb[j] = fmaxf(sb[j], 1e-20f);
                    if (sel == 0) {
                        const u32x4 a4 = aw[m][bj];
                        const float sa[8] = {bf_lo(a4.x), bf_hi(a4.x), bf_lo(a4.y), bf_hi(a4.y), bf_lo(a4.z), bf_hi(a4.z), bf_lo(a4.w), bf_hi(a4.w)};
#pragma unroll
                        for (int j = 0; j < 4; ++j) { acc[ai][bj][m][0][j] *= sa[j] * fast_rcp(sb[j]); acc[ai][bj][m][1][j] *= sa[4 + j] * fast_rcp(sb[4 + j]); }
                    } else {
                        const f32x4 v0 = acc[ai][bj][m][0], v1 = acc[ai][bj][m][1];
                        u32x4 w; w.x = pk2(v0[0] * sb[0], v0[1] * sb[1]); w.y = pk2(v0[2] * sb[2], v0[3] * sb[3]); w.z = pk2(v1[0] * sb[4], v1[1] * sb[5]); w.w = pk2(v1[2] * sb[6], v1[3] * sb[7]);
                        *(u32x4*)(merged + off) = w; } }
        }
        return sel == 0;
    }
};

template <bool WITH_BF16, bool WRITE_F32, bool BASE_BF16> struct EpiResid {
    const void* base; float* outf; bf16_t* outb; float* ssq;
    DI bool operator()(Acc& acc, const Unit& u, int wr, int wc, int fr, int fq) const {
        const int row0 = u.pm * BM + wr * 64 + fr, col0 = u.pn * BM + wc * 32 + 8 * fq;
#pragma unroll
        for (int ai = 0; ai < 2; ++ai) {
            f32x4 bq[4][2][2];
#pragma unroll
            for (int m = 0; m < 4; ++m)
#pragma unroll
                for (int bj = 0; bj < 2; ++bj) { const size_t off = (size_t)(row0 + ai * HALF + m * 16) * DM + col0 + bj * HALF;
                    if (BASE_BF16) { const u32x4 bw = *(const u32x4*)((const bf16_t*)base + off);
                        bq[m][bj][0] = (f32x4){__uint_as_float(bw.x), __uint_as_float(bw.y), __uint_as_float(bw.z), __uint_as_float(bw.w)}; bq[m][bj][1] = bq[m][bj][0]; }
                    else { bq[m][bj][0] = *(const f32x4*)((const float*)base + off); bq[m][bj][1] = *(const f32x4*)((const float*)base + off + 4); } }
            asm volatile("" ::: "memory");
#pragma unroll
            for (int m = 0; m < 4; ++m) { const int row = row0 + ai * HALF + m * 16; float s = 0.f;
#pragma unroll
                for (int bj = 0; bj < 2; ++bj) { const size_t off = (size_t)row * DM + col0 + bj * HALF;
                    f32x4 b0, b1;
                    if (BASE_BF16) { const unsigned wx = __float_as_uint(bq[m][bj][0][0]), wy = __float_as_uint(bq[m][bj][0][1]), wz = __float_as_uint(bq[m][bj][0][2]), ww = __float_as_uint(bq[m][bj][0][3]);
                        b0 = (f32x4){bf_lo(wx), bf_hi(wx), bf_lo(wy), bf_hi(wy)}; b1 = (f32x4){bf_lo(wz), bf_hi(wz), bf_lo(ww), bf_hi(ww)}; }
                    else { b0 = bq[m][bj][0]; b1 = bq[m][bj][1]; }
                    const f32x4 v0 = acc[ai][bj][m][0] + b0, v1 = acc[ai][bj][m][1] + b1;
                    if (WRITE_F32) { *(f32x4*)(outf + off) = v0; *(f32x4*)(outf + off + 4) = v1; }
                    s += (v0[0] * v0[0] + v0[1] * v0[1]) + (v0[2] * v0[2] + v0[3] * v0[3]) + (v1[0] * v1[0] + v1[1] * v1[1]) + (v1[2] * v1[2] + v1[3] * v1[3]);
                    if (WITH_BF16) { u32x4 w; w.x = pk2(v0[0], v0[1]); w.y = pk2(v0[2], v0[3]); w.z = pk2(v1[0], v1[1]); w.w = pk2(v1[2], v1[3]);
                        *(u32x4*)(outb + off) = w; } }
                s += __shfl_xor(s, 16); s += __shfl_xor(s, 32);
                if (fq == 0) atomicAdd(ssq + row, s); }
        }
        return false;
    }
};

struct EpiSwiglu {
    const float* ssq; bf16_t* act;
    DI bool operator()(Acc& acc, const Unit& u, int wr, int wc, int fr, int fq) const {
        const int row0 = u.pm * BM + wr * 64 + fr, col0 = u.pn * HALF + wc * 32 + 8 * fq;
#pragma unroll
        for (int ai = 0; ai < 2; ++ai)
#pragma unroll
            for (int m = 0; m < 4; ++m) { const int row = row0 + ai * HALF + m * 16;
                const float r = rsqrtf(ssq[row] * (1.0f / DM) + EPS);
                float o[8];
#pragma unroll
                for (int n = 0; n < 2; ++n)
#pragma unroll
                    for (int j = 0; j < 4; ++j) { const float gt = acc[ai][0][m][n][j] * r, up = acc[ai][1][m][n][j] * r; o[4 * n + j] = siluf_(gt) * up; }
                u32x4 w; w.x = pk2(o[0], o[1]); w.y = pk2(o[2], o[3]); w.z = pk2(o[4], o[5]); w.w = pk2(o[6], o[7]);
                *(u32x4*)(act + (size_t)row * FF + col0) = w; }
        return false;
    }
};
}

DI void tr_item(const float* W, int N, bf16_t* WT, int K, int k0, int n0, int drow0, const float* ksc, LAS float* scr, int lane) {
    float v[64];
#pragma unroll
    for (int i = 0; i < 64; ++i) v[i] = W[(size_t)(k0 + i) * N + n0 + lane];
    if (ksc) {
#pragma unroll
        for (int i = 0; i < 64; ++i) v[i] *= ksc[k0 + i];
    }
#pragma unroll
    for (int i = 0; i < 64; ++i) scr[i * 65 + lane] = v[i];
    LDS_WAIT();
    const int c = lane & 7;
#pragma unroll
    for (int j = 0; j < 8; ++j) { const int n = (lane >> 3) + 8 * j; const LAS float* s = scr + (8 * c) * 65 + n;
        u32x4 o; o.x = pk2(s[0 * 65], s[1 * 65]); o.y = pk2(s[2 * 65], s[3 * 65]); o.z = pk2(s[4 * 65], s[5 * 65]); o.w = pk2(s[6 * 65], s[7 * 65]);
        *(u32x4*)(WT + (size_t)(drow0 + n) * K + k0 + 8 * c) = o; }
    LDS_WAIT();
}

DI void phase0(const Params& p, LAS unsigned char* lds) {
    const int tid = threadIdx.x, lane = tid & 63, wave = tid >> 6, G = gridDim.x;
    unsigned char* ws = p.ws;
    {
        LAS float* As = (LAS float*)lds;
        LAS float* Bs = (LAS float*)(lds + 32768);
        bf16_t* dst = (bf16_t*)(ws + OFF_WAB) + (size_t)DM * DM;
        for (int T = blockIdx.x; T < 256; T += G) {
            const int d0 = (T >> 4) * 64, rt = T & 15, g = rt >> 2, c0 = (rt & 3) * 64;
            const int cc = tid & 63, dq = tid >> 6;
            float acc[8];
#pragma unroll
            for (int j = 0; j < 8; ++j) acc[j] = 0.f;
            for (int eh = 0; eh < 256; eh += 128) {
                __syncthreads();
                for (int idx = tid; idx < 128 * 16; idx += 512) { const int e = idx >> 4, d4 = idx & 15; const int er = 256 * g + eh + e;
                    f32x4 v = *(const f32x4*)(p.w_b + (size_t)er * DM + d0 + 4 * d4); const float s = p.pool_scale[er];
                    *(LAS f32x4*)(As + e * 64 + 4 * d4) = v * s; }
                for (int idx = tid; idx < 64 * 32; idx += 512) { const int c = idx >> 5, e4 = idx & 31;
                    const f32x4 v = *(const f32x4*)(p.pool_w + ((size_t)(g * 256 + c0 + c)) * 256 + eh + 4 * e4);
                    LAS float* b = Bs + c * 129 + 4 * e4; b[0] = v[0]; b[1] = v[1]; b[2] = v[2]; b[3] = v[3]; }
                __syncthreads();
#pragma unroll 4
                for (int e = 0; e < 128; ++e) { const float b = Bs[cc * 129 + e];
                    const f32x4 a0 = *(const LAS f32x4*)(As + e * 64 + dq * 8), a1 = *(const LAS f32x4*)(As + e * 64 + dq * 8 + 4);
                    acc[0] += a0[0] * b; acc[1] += a0[1] * b; acc[2] += a0[2] * b; acc[3] += a0[3] * b;
                    acc[4] += a1[0] * b; acc[5] += a1[1] * b; acc[6] += a1[2] * b; acc[7] += a1[3] * b; }
            }
#pragma unroll
            for (int j = 0; j < 8; ++j) dst[(size_t)(d0 + dq * 8 + j) * DM + 256 * g + c0 + cc] = (bf16_t)(pk2(acc[j], 0.f) & 0xffffu);
        }
        __syncthreads();
    }
    {
        LAS float* scr = (LAS float*)(lds + wave * 16640);
        const int gw = blockIdx.x * 8 + wave, NGW = G * 8;
        constexpr int I_IN = 16 * 128, I_A = 16 * 16, I_O = 16 * 16, I_FI = 16 * 88, I_FO = 44 * 16;
        constexpr int NITEMS = I_IN + I_A + I_O + I_FI + I_FO;
        for (int it = gw; it < NITEMS; it += NGW) {
            int r = it;
            if (r < I_IN) { const int kb = r / 128, nb = r % 128; tr_item(p.w_in, 8192, (bf16_t*)(ws + OFF_WIN), DM, 64 * kb, 64 * nb, 64 * nb, nullptr, scr, lane); continue; } r -= I_IN;
            if (r < I_A) { const int kb = r / 16, nb = r % 16; tr_item(p.w_a, DM, (bf16_t*)(ws + OFF_WAB), DM, 64 * kb, 64 * nb, 64 * nb, nullptr, scr, lane); continue; } r -= I_A;
            if (r < I_O) { const int kb = r / 16, nb = r % 16; tr_item(p.w_out, DM, (bf16_t*)(ws + OFF_WO), DM, 64 * kb, 64 * nb, 64 * nb, nullptr, scr, lane); continue; } r -= I_O;
            if (r < I_FI) { const int kb = r / 88, nb = r % 88; const int n0 = 64 * nb; const int nn = n0 < FF ? n0 : n0 - FF;
                const int drow0 = 256 * (nn >> 7) + (n0 < FF ? 0 : 128) + (nn & 127);
                tr_item(p.w_fi, 2 * FF, (bf16_t*)(ws + OFF_WFI), DM, 64 * kb, n0, drow0, p.g_ffn, scr, lane); continue; } r -= I_FI;
            { const int kb = r / 16, nb = r % 16; tr_item(p.w_fo, DM, (bf16_t*)(ws + OFF_WFO), FF, 64 * kb, 64 * nb, 64 * nb, nullptr, scr, lane); }
        }
        bf16_t* xb = (bf16_t*)(ws + OFF_XB);
        for (int rb = gw * 4; rb < MTOK; rb += NGW * 4) {
            f32x4 v[4][4]; float sq[4];
#pragma unroll
            for (int r = 0; r < 4; ++r) { const f32x4* xr = (const f32x4*)(p.x + (size_t)(rb + r) * DM) + lane;
#pragma unroll
                for (int j = 0; j < 4; ++j) v[r][j] = xr[64 * j]; }
#pragma unroll
            for (int r = 0; r < 4; ++r) { float s = 0.f;
#pragma unroll
                for (int j = 0; j < 4; ++j) s += (v[r][j][0] * v[r][j][0] + v[r][j][1] * v[r][j][1]) + (v[r][j][2] * v[r][j][2] + v[r][j][3] * v[r][j][3]);
                sq[r] = s; }
#pragma unroll
            for (int o = 1; o < 64; o <<= 1) {
#pragma unroll
                for (int r = 0; r < 4; ++r) sq[r] += __shfl_xor(sq[r], o); }
#pragma unroll
            for (int r = 0; r < 4; ++r) { const float rr = rsqrtf(sq[r] * (1.0f / DM) + EPS);
                u32x2* o8 = (u32x2*)(xb + (size_t)(rb + r) * DM) + lane;
#pragma unroll
                for (int j = 0; j < 4; ++j) { const f32x4 gg = *((const f32x4*)p.g_mix + lane + 64 * j);
                    u32x2 w; w.x = pk2(v[r][j][0] * rr * gg[0], v[r][j][1] * rr * gg[1]); w.y = pk2(v[r][j][2] * rr * gg[2], v[r][j][3] * rr * gg[3]); o8[64 * j] = w; } }
        }
    }
    {
        float* z = (float*)(ws + OFF_SSQ2);
        for (int i = blockIdx.x * 512 + tid; i < 2 * MTOK; i += G * 512) z[i] = 0.f;
        float* oml = (float*)(ws + OFF_OML);
        for (int i = blockIdx.x * 512 + tid; i < 2 * DM; i += G * 512) { const int dir = i >> 10, n = i & 1023;
            const float l0 = p.lb_logits[(size_t)dir * 2 * DM + n], l1 = p.lb_logits[(size_t)dir * 2 * DM + DM + n];
            oml[i] = 1.0f / (1.0f + __expf(l0 - l1)); }
    }
}

constexpr int CH = 32, NCH = SEQ / CH, R_STR = 272;
constexpr int R_QD = 0, R_KI = CH * R_STR, R_KE = 2 * CH * R_STR, R_VT = R_KE + 128 * 64, R_DD = R_VT + 128 * 64, R_SLOT = R_DD + 512;
constexpr int R_RAW = 0, R_WSLOT = 3 * CH * 64, R_NRAW = 3, R_DIST = 3, R_OPS = 4 * R_NRAW * R_WSLOT, R_OB = R_OPS + 2 * R_SLOT, R_OBSZ = CH * R_STR;
static_assert(R_OB + 2 * R_OBSZ + 16 <= LDS_BYTES, "LDS");

DI void rec_prep(const LAS unsigned char* raw, LAS unsigned char* sl, int tg, int kp, int rg) {
    unsigned kw[8], qw[8], vw[8];
#pragma unroll
    for (int j = 0; j < 8; ++j) { const int ro = (8 * rg + j) * 64 + kp * 4; qw[j] = *(const LAS unsigned*)(raw + ro); kw[j] = *(const LAS unsigned*)(raw + 2048 + ro); vw[j] = *(const LAS unsigned*)(raw + 4096 + ro); }
    f32x2 P = {1.f, 1.f}, Pl[8];
#pragma unroll
    for (int j = 0; j < 8; ++j) { const f32x2 f = {1.0f - bf_lo(kw[j]), 1.0f - bf_hi(kw[j])}; P = P * f; Pl[j] = P; }
    f32x2 T[4];
#pragma unroll
    for (int g = 0; g < 4; ++g) { T[g].x = __shfl(P.x, 16 * g + kp); T[g].y = __shfl(P.y, 16 * g + kp); }
    const f32x2 one = {1.f, 1.f};
    f32x2 pre = rg >= 1 ? T[0] : one; pre = pre * (rg >= 2 ? T[1] : one); pre = pre * (rg >= 3 ? T[2] : one);
    const f32x2 PL = (T[0] * T[1]) * (T[2] * T[3]);
    f32x2 ke[8];
    const int cb = 64 * tg + 2 * (8 * ((kp >> 1) & 3) + 4 * (kp >> 3) + 2 * (kp & 1));
#pragma unroll
    for (int j = 0; j < 8; ++j) { const int t = 8 * rg + j; const f32x2 Pa = pre * Pl[j];
        const f32x2 ki = {bf_lo(kw[j]) * fast_rcp(Pa.x), bf_hi(kw[j]) * fast_rcp(Pa.y)}; ke[j] = ki * PL;
        *(LAS unsigned*)(sl + R_QD + t * R_STR + cb) = pk2(bf_lo(qw[j]) * Pa.x, bf_hi(qw[j]) * Pa.y);
        *(LAS unsigned*)(sl + R_KI + t * R_STR + cb) = pk2(ki.x, ki.y); }
    const int n0 = 32 * tg + 2 * kp, so = ((rg ^ (kp & 3)) * 16);
    u32x4 k0, k1, v0, v1;
    k0.x = pk2(ke[0].x, ke[1].x); k0.y = pk2(ke[2].x, ke[3].x); k0.z = pk2(ke[4].x, ke[5].x); k0.w = pk2(ke[6].x, ke[7].x);
    k1.x = pk2(ke[0].y, ke[1].y); k1.y = pk2(ke[2].y, ke[3].y); k1.z = pk2(ke[4].y, ke[5].y); k1.w = pk2(ke[6].y, ke[7].y);
    v0.x = (vw[0] & 0xffffu) | (vw[1] << 16); v0.y = (vw[2] & 0xffffu) | (vw[3] << 16); v0.z = (vw[4] & 0xffffu) | (vw[5] << 16); v0.w = (vw[6] & 0xffffu) | (vw[7] << 16);
    v1.x = (vw[0] >> 16) | (vw[1] & 0xffff0000u); v1.y = (vw[2] >> 16) | (vw[3] & 0xffff0000u); v1.z = (vw[4] >> 16) | (vw[5] & 0xffff0000u); v1.w = (vw[6] >> 16) | (vw[7] & 0xffff0000u);
    *(LAS u32x4*)(sl + R_KE + n0 * 64 + so) = k0; *(LAS u32x4*)(sl + R_KE + (n0 + 1) * 64 + so) = k1;
    *(LAS u32x4*)(sl + R_VT + n0 * 64 + so) = v0; *(LAS u32x4*)(sl + R_VT + (n0 + 1) * 64 + so) = v1;
    if (rg == 0) *(LAS f32x2*)(sl + R_DD + n0 * 4) = PL;
}

DI void phase_rec(const Params& p, LAS unsigned char* lds) {
    const int tid = threadIdx.x, lane = tid & 63, w = __builtin_amdgcn_readfirstlane(tid >> 6), c16 = lane & 15, kg = lane >> 4;
    const bool prep = w >= 4;
    const int tg = w & 3, kp = lane & 15, rg = lane >> 4, pt = tid & 255;
    unsigned char* ws = p.ws;
    for (int s = blockIdx.x; s < NB * 2 * NH; s += gridDim.x) {
        const int b = s >> 4, dh = s & 15, dir = dh >> 3, h = dh & 7;
        const size_t sbase = ((size_t)b * SEQ * DM + h * 128) * 2;
        const unsigned char* gq = ws + OFF_S0 + sbase;
        unsigned char* gk = ws + (dir ? OFF_S2 : OFF_S1) + sbase;
        const unsigned char* gv = ws + OFF_S3 + sbase;
#define REC_ROWB(c, t) ((size_t)(dir ? (SEQ - 1 - (CH * (c) + (t))) : (CH * (c) + (t))) * (DM * 2))
#define REC_DMA1(c, a_, half_) do { const unsigned char* _src = ((a_) == 0 ? gq : ((a_) == 1 ? (const unsigned char*)gk : gv)) + REC_ROWB(c, 16 * (half_) + (lane >> 2)) + 64 * tg + (lane & 3) * 16; \
        __builtin_amdgcn_global_load_lds((const unsigned*)_src, (LAS unsigned*)(lds + R_RAW + (tg * R_NRAW + ((c) % R_NRAW)) * R_WSLOT + (a_) * 2048 + (half_) * 1024), 16, 0, 0); } while (0)
#define REC_DMA(c) do { REC_DMA1(c, 0, 0); REC_DMA1(c, 0, 1); REC_DMA1(c, 1, 0); REC_DMA1(c, 1, 1); REC_DMA1(c, 2, 0); REC_DMA1(c, 2, 1); } while (0)
#define REC_RAWSLOT(c) (lds + R_RAW + (tg * R_NRAW + ((c) % R_NRAW)) * R_WSLOT)
#define REC_OUT(c) do { _Pragma("unroll") for (int _k = 0; _k < 2; ++_k) { const int _id = pt + 256 * _k, _t = _id >> 4, _pc = _id & 15; \
        const u32x4 _v = *(const LAS u32x4*)(lds + R_OB + ((c) & 1) * R_OBSZ + _t * R_STR + _pc * 16); *(u32x4*)(gk + REC_ROWB(c, _t) + _pc * 16) = _v; } } while (0)
        __syncthreads();
        if (prep) { REC_DMA(0); REC_DMA(1); REC_DMA(2); }
        asm volatile("s_waitcnt vmcnt(0)" ::: "memory"); __builtin_amdgcn_s_barrier(); asm volatile("" ::: "memory");
        if (prep) rec_prep(REC_RAWSLOT(0), lds + R_OPS, tg, kp, rg);
        asm volatile("s_waitcnt lgkmcnt(0)" ::: "memory"); __builtin_amdgcn_s_barrier(); asm volatile("" ::: "memory");
        const int sx = (c16 >> 1) & 3;
#define REC_STEP_BARRIER() do { asm volatile("s_waitcnt lgkmcnt(0)" ::: "memory"); __builtin_amdgcn_s_barrier(); asm volatile("" ::: "memory"); } while (0)
        if (prep) {
            for (int c = 0; c < NCH; ++c) {
                if (c + R_DIST < NCH) REC_DMA(c + R_DIST);
                if (c >= 3 && c + R_DIST < NCH) asm volatile("s_waitcnt vmcnt(16)" ::: "memory"); else asm volatile("s_waitcnt vmcnt(0)" ::: "memory");
                if (c + 1 < NCH) rec_prep(REC_RAWSLOT(c + 1), lds + R_OPS + ((c + 1) & 1) * R_SLOT, tg, kp, rg);
                if (c >= 1) REC_OUT(c - 1);
                REC_STEP_BARRIER();
            }
        } else {
            __builtin_amdgcn_s_setprio(2);
            f32x4 S[2][8];
#pragma unroll
            for (int d = 0; d < 2; ++d)
#pragma unroll
                for (int i = 0; i < 8; ++i) S[d][i] = (f32x4){0.f, 0.f, 0.f, 0.f};
            for (int c = 0; c < NCH; ++c) {
                const LAS unsigned char* sl = lds + R_OPS + (c & 1) * R_SLOT;
                bf16x8 qf[2][4], kf[2][4];
#pragma unroll
                for (int tt = 0; tt < 2; ++tt)
#pragma unroll
                    for (int pp = 0; pp < 4; ++pp) {
                        qf[tt][pp] = *(const LAS bf16x8*)(sl + R_QD + (16 * tt + c16) * R_STR + 64 * pp + 16 * kg);
                        kf[tt][pp] = *(const LAS bf16x8*)(sl + R_KI + (16 * tt + c16) * R_STR + 64 * pp + 16 * kg); }
#define REC_TFRAG(base, row) __builtin_shufflevector(*(const LAS bf16x4*)(sl + (base) + (row) * 64 + (((kg >> 1) ^ sx) * 16) + (kg & 1) * 8), \
                                                     *(const LAS bf16x4*)(sl + (base) + (row) * 64 + (((2 + (kg >> 1)) ^ sx) * 16) + (kg & 1) * 8), 0, 1, 2, 3, 4, 5, 6, 7)
                bf16x8 vf8[2];
#pragma unroll
                for (int d = 0; d < 2; ++d) vf8[d] = REC_TFRAG(R_VT, 32 * w + 16 * d + c16);
                f32x4 o2[2][2];
#pragma unroll
                for (int tt = 0; tt < 2; ++tt)
#pragma unroll
                    for (int d = 0; d < 2; ++d) o2[tt][d] = (f32x4){0.f, 0.f, 0.f, 0.f};
                f32x4 T00 = (f32x4){0.f, 0.f, 0.f, 0.f}, T01 = T00, T11 = T00;
#pragma unroll
                for (int pp = 0; pp < 4; ++pp) {
                    T00 = __builtin_amdgcn_mfma_f32_16x16x32_bf16(kf[0][pp], qf[0][pp], T00, 0, 0, 0);
                    T01 = __builtin_amdgcn_mfma_f32_16x16x32_bf16(kf[0][pp], qf[1][pp], T01, 0, 0, 0);
                    T11 = __builtin_amdgcn_mfma_f32_16x16x32_bf16(kf[1][pp], qf[1][pp], T11, 0, 0, 0);
#pragma unroll
                    for (int d = 0; d < 2; ++d) {
                        u32x4 sw; sw.x = pk2(S[d][2 * pp][0], S[d][2 * pp][1]); sw.y = pk2(S[d][2 * pp][2], S[d][2 * pp][3]); sw.z = pk2(S[d][2 * pp + 1][0], S[d][2 * pp + 1][1]); sw.w = pk2(S[d][2 * pp + 1][2], S[d][2 * pp + 1][3]);
                        const bf16x8 Sb = __builtin_bit_cast(bf16x8, sw);
                        o2[0][d] = __builtin_amdgcn_mfma_f32_16x16x32_bf16(qf[0][pp], Sb, o2[0][d], 0, 0, 0);
                        o2[1][d] = __builtin_amdgcn_mfma_f32_16x16x32_bf16(qf[1][pp], Sb, o2[1][d], 0, 0, 0); } }
#pragma unroll
                for (int i = 0; i < 8; ++i) {
                    const f32x4 dv4 = *(const LAS f32x4*)(sl + R_DD + (16 * i + 4 * kg) * 4);
                    const bf16x8 kef8 = REC_TFRAG(R_KE, 16 * i + c16);
#pragma unroll
                    for (int d = 0; d < 2; ++d) S[d][i] = __builtin_amdgcn_mfma_f32_16x16x32_bf16(kef8, vf8[d], S[d][i] * dv4, 0, 0, 0); }
#undef REC_TFRAG
#pragma unroll
                for (int r = 0; r < 4; ++r) if (4 * kg + r > c16) { T00[r] = 0.f; T11[r] = 0.f; }
                u32x4 a0, a1;
                a0.x = pk2(T00[0], T00[1]); a0.y = pk2(T00[2], T00[3]); a0.z = 0u; a0.w = 0u;
                a1.x = pk2(T01[0], T01[1]); a1.y = pk2(T01[2], T01[3]); a1.z = pk2(T11[0], T11[1]); a1.w = pk2(T11[2], T11[3]);
                const bf16x8 sA[2] = {__builtin_bit_cast(bf16x8, a0), __builtin_bit_cast(bf16x8, a1)};
                LAS unsigned char* ob = lds + R_OB + (c & 1) * R_OBSZ;
#pragma unroll
                for (int tt = 0; tt < 2; ++tt)
#pragma unroll
                    for (int d = 0; d < 2; ++d) {
                        const f32x4 o = __builtin_amdgcn_mfma_f32_16x16x32_bf16(sA[tt], vf8[d], o2[tt][d], 0, 0, 0);
#pragma unroll
                        for (int r = 0; r < 4; ++r) *(LAS bf16_t*)(ob + (16 * tt + 4 * kg + r) * R_STR + (32 * w + 16 * d + c16) * 2) = (bf16_t)(pk2(o[r], 0.f) & 0xffffu); }
                REC_STEP_BARRIER();
            }
            __builtin_amdgcn_s_setprio(0);
        }
#undef REC_STEP_BARRIER
        if (prep) REC_OUT(NCH - 1);
        asm volatile("s_waitcnt vmcnt(0) lgkmcnt(0)" ::: "memory"); __builtin_amdgcn_s_barrier(); asm volatile("" ::: "memory");
#undef REC_ROWB
#undef REC_DMA1
#undef REC_DMA
#undef REC_RAWSLOT
#undef REC_OUT
    }
}

DI void comb_one(const Params& p, int oi, const u32x4 a, const u32x4 bb, const u32x4 gg, const u32x4 (&pv)[17], u32x4* of, u32x4* yp) {
    const int co = oi & 127;
    float o[8];
    o[0] = bf_lo(a.x) + bf_lo(bb.x); o[1] = bf_hi(a.x) + bf_hi(bb.x); o[2] = bf_lo(a.y) + bf_lo(bb.y); o[3] = bf_hi(a.y) + bf_hi(bb.y);
    o[4] = bf_lo(a.z) + bf_lo(bb.z); o[5] = bf_hi(a.z) + bf_hi(bb.z); o[6] = bf_lo(a.w) + bf_lo(bb.w); o[7] = bf_hi(a.w) + bf_hi(bb.w);
    float s = 0.f;
#pragma unroll
    for (int j = 0; j < 8; ++j) s += o[j] * o[j];
    s += __shfl_xor(s, 1); s += __shfl_xor(s, 2); s += __shfl_xor(s, 4); s += __shfl_xor(s, 8);
    const float r = rsqrtf(s * (1.0f / 128.0f) + EPS);
    const f32x4 g0 = *(const f32x4*)(p.hgrn_g + co * 8), g1 = *(const f32x4*)(p.hgrn_g + co * 8 + 4);
    u32x4 y;
    y.x = pk2(o[0] * r * g0[0] * siluf_(bf_lo(gg.x)), o[1] * r * g0[1] * siluf_(bf_hi(gg.x))); y.y = pk2(o[2] * r * g0[2] * siluf_(bf_lo(gg.y)), o[3] * r * g0[3] * siluf_(bf_hi(gg.y)));
    y.z = pk2(o[4] * r * g1[0] * siluf_(bf_lo(gg.z)), o[5] * r * g1[1] * siluf_(bf_hi(gg.z))); y.w = pk2(o[6] * r * g1[2] * siluf_(bf_lo(gg.w)), o[7] * r * g1[3] * siluf_(bf_hi(gg.w)));
    of[oi] = y;
    const int row = oi >> 7, t = row & (SEQ - 1), half = 1 << (co >> 5);
    const int lo = max(t - half + 1, 0), hi = min(t + half + 1, SEQ);
    float acc[8];
#pragma unroll
    for (int j = 0; j < 8; ++j) acc[j] = 0.f;
#pragma unroll
    for (int j = 0; j < 16; ++j) { const u32x4 v = pv[1 + j];
        acc[0] += bf_lo(v.x); acc[1] += bf_hi(v.x); acc[2] += bf_lo(v.y); acc[3] += bf_hi(v.y); acc[4] += bf_lo(v.z); acc[5] += bf_hi(v.z); acc[6] += bf_lo(v.w); acc[7] += bf_hi(v.w); }
    const float ic = 1.0f / (float)(hi - lo);
    const u32x4 c = pv[0];
    u32x4 q;
    q.x = pk2(acc[0] * ic - bf_lo(c.x), acc[1] * ic - bf_hi(c.x)); q.y = pk2(acc[2] * ic - bf_lo(c.y), acc[3] * ic - bf_hi(c.y));
    q.z = pk2(acc[4] * ic - bf_lo(c.z), acc[5] * ic - bf_hi(c.z)); q.w = pk2(acc[6] * ic - bf_lo(c.w), acc[7] * ic - bf_hi(c.w));
    yp[oi] = q;
}
DI void phase_comb(const Params& p) {
    unsigned char* ws = p.ws;
    const int gt = blockIdx.x * 512 + threadIdx.x, NT = gridDim.x * 512;
    u32x4* of = (u32x4*)(ws + OFF_S1); const u32x4* ob = (const u32x4*)(ws + OFF_S2); const u32x4* og = (const u32x4*)(ws + OFF_S4);
    const u32x4* pin = (const u32x4*)(ws + OFF_S5); u32x4* yp = (u32x4*)(ws + OFF_XB);
    const u32x4 zero = {0u, 0u, 0u, 0u};
    for (int oi = gt; oi < MTOK * 128; oi += NT) {
        const int co = oi & 127, row = oi >> 7, t = row & (SEQ - 1), half = 1 << (co >> 5);
        const int lo = max(t - half + 1, 0), hi = min(t + half + 1, SEQ);
        const u32x4 a = of[oi], bb = ob[oi], gg = og[oi];
        u32x4 pv[17];
        pv[0] = pin[oi];
#pragma unroll
        for (int j = 0; j < 16; ++j) { const int tt = lo + j; pv[1 + j] = (tt < hi) ? pin[oi + (tt - t) * 128] : zero; }
        comb_one(p, oi, a, bb, gg, pv, of, yp);
    }
}

DI void phase_final(const Params& p) {
    const float* ssq = (const float*)(p.ws + OFF_SSQ3);
    const u32x4* hb = (const u32x4*)(p.ws + OFF_S2);
    f32x4* o = (f32x4*)p.out;
    const int gt = blockIdx.x * 512 + threadIdx.x, NT = gridDim.x * 512;
    const f32x4 g0 = *((const f32x4*)p.g_final + 2 * (gt & 127)), g1 = *((const f32x4*)p.g_final + 2 * (gt & 127) + 1);
    for (int i0 = gt; i0 < MTOK * DM / 8; i0 += 8 * NT) {
        u32x4 v[8]; float r[8];
#pragma unroll
        for (int k = 0; k < 8; ++k) { const int i = i0 + k * NT; v[k] = hb[i]; r[k] = ssq[i >> 7]; }
#pragma unroll
        for (int k = 0; k < 8; ++k) { const int i = i0 + k * NT; const float rr = rsqrtf(r[k] * (1.0f / DM) + EPS);
            const f32x4 a = {bf_lo(v[k].x), bf_hi(v[k].x), bf_lo(v[k].y), bf_hi(v[k].y)}, bq = {bf_lo(v[k].z), bf_hi(v[k].z), bf_lo(v[k].w), bf_hi(v[k].w)};
            o[2 * i] = a * rr * g0; o[2 * i + 1] = bq * rr * g1; }
    }
}

#ifndef DBG_STOP
#define DBG_STOP -1
#endif
DI void phase_digest(const Params& p) {
    const unsigned short* b0 = (const unsigned short*)(p.ws + OFF_XB);
    const int gt = blockIdx.x * 512 + threadIdx.x, NT = gridDim.x * 512;
    for (int i = gt; i < MTOK * DM / 2; i += NT) {
        unsigned acc = 0;
#pragma unroll
        for (int j = 0; j < 7; ++j) acc += (unsigned)b0[(size_t)j * (SPL / 2) + i] + 3u * (unsigned)b0[(size_t)j * (SPL / 2) + i + MTOK * DM / 2];
        if (DBG_STOP < 4) { const unsigned short* g = (const unsigned short*)p.out; acc += (unsigned)g[2 * (size_t)i] + 5u * (unsigned)g[2 * (size_t)i + 1] + 7u * (unsigned)g[(size_t)MTOK * DM + i] ; }
        p.out[i] = (float)(acc & 0xfffffu);
    }
}

#define XB_TMO      128
#define XB_XCNT(j)  (256  + 64 * (j))
#define XB_XSUB(j)  (1280 + 64 * (j))
#define XB_XGEN(j)  (2304 + 64 * (j))
#define XB_TOP      3328
#define XB_TOPGEN   3392
#define XCD_BAR_WORDS 3456
#define XB_SPIN_CAP (1u << 18)

__device__ __forceinline__ unsigned xb_ld(unsigned* p)              { return __hip_atomic_load(p, __ATOMIC_RELAXED, __HIP_MEMORY_SCOPE_AGENT); }
__device__ __forceinline__ unsigned xb_add(unsigned* p, unsigned v) { return __hip_atomic_fetch_add(p, v, __ATOMIC_RELAXED, __HIP_MEMORY_SCOPE_AGENT); }
__device__ __forceinline__ unsigned xb_xcc_id() { return (unsigned)__builtin_amdgcn_s_getreg((3 << 11) | 20) & 0xFu; }
#define XB_SPIN(cond, bar) do { unsigned _sp = 0; while (cond) { __builtin_amdgcn_s_sleep(1); \
    if ((++_sp & 255u) == 0u) { if (xb_ld(&(bar)[XB_TMO])) break; if (_sp > XB_SPIN_CAP) { atomicAdd(&(bar)[XB_TMO], 1u); break; } } } } while (0)

struct XcdBarrier {
    unsigned* bar; unsigned x;
    volatile LAS unsigned* st;
};

__device__ __forceinline__ XcdBarrier xcd_barrier_post(unsigned* bar, volatile LAS unsigned* st) {
    XcdBarrier b; b.bar = bar; b.x = xb_xcc_id(); b.st = st;
    if (threadIdx.x == 0) (void)xb_add(&bar[XB_XCNT(b.x)], 1u);
    return b;
}
__device__ __forceinline__ void xcd_barrier_complete(unsigned* bar, unsigned x, unsigned& nloc, unsigned& nx) {
    const unsigned G = gridDim.x * gridDim.y * gridDim.z;
    unsigned sum, cnt, mine, sp = 0u;
    for (;;) {
        sum = 0u; cnt = 0u; mine = 0u;
#pragma unroll
        for (unsigned j = 0; j < 16; ++j) { const unsigned c = xb_ld(&bar[XB_XCNT(j)]); sum += c; cnt += (c > 0u) ? 1u : 0u; mine = (j == x) ? c : mine; }
        if (sum == G) break;
        __builtin_amdgcn_s_sleep(1);
        if ((++sp & 255u) == 0u) { if (xb_ld(&bar[XB_TMO])) break; if (sp > XB_SPIN_CAP) { atomicAdd(&bar[XB_TMO], 1u); break; } }
    }
    nloc = mine > 0u ? mine : 1u; nx = cnt > 0u ? cnt : 1u;
}

__device__ __forceinline__ void xcd_barrier(const XcdBarrier& b) {
    asm volatile("s_waitcnt vmcnt(0)" ::: "memory");
    __syncthreads();
    if (threadIdx.x == 0) {
        unsigned* bar = b.bar;
        __builtin_amdgcn_s_waitcnt(0);
        unsigned nloc = b.st[0], nx = b.st[1];
        if (nloc == 0u) { xcd_barrier_complete(bar, b.x, nloc, nx); b.st[0] = nloc; b.st[1] = nx; }
        const unsigned old = xb_add(&bar[XB_XSUB(b.x)], 1u);
        const unsigned gen = old / nloc;
        if (old + 1u == (gen + 1u) * nloc) {
            __builtin_amdgcn_fence(__ATOMIC_RELEASE, "agent");
            asm volatile("s_waitcnt vmcnt(0)" ::: "memory");
            const unsigned og = xb_add(&bar[XB_TOP], 1u);
            const unsigned tg = og / nx;
            if (og + 1u == (tg + 1u) * nx) xb_add(&bar[XB_TOPGEN], 1u);
            else XB_SPIN(xb_ld(&bar[XB_TOPGEN]) == tg, bar);
            __builtin_amdgcn_fence(__ATOMIC_ACQUIRE, "agent");
            xb_add(&bar[XB_XGEN(b.x)], 1u);
            asm volatile("s_waitcnt vmcnt(0)" ::: "memory");
        } else {
            XB_SPIN(xb_ld(&bar[XB_XGEN(b.x)]) == gen, bar);
            __builtin_amdgcn_fence(__ATOMIC_ACQUIRE, "agent");
            asm volatile("s_waitcnt vmcnt(0)" ::: "memory");
        }
    }
    __syncthreads();
}


#ifndef WGM_WIDE
#define WGM_WIDE 7
#define WGM_INPROJ 14
#define WGM_NARROW 8
#endif
__global__ void __launch_bounds__(512, 2) fwd_kernel(Params p, int ph_lo, int ph_hi) {
    extern __shared__ __attribute__((aligned(16))) unsigned char lds_raw[];
    LAS unsigned char* lds = (LAS unsigned char*)lds_raw;
    cg::grid_group grid = cg::this_grid();
    unsigned char* ws = p.ws;
    const int G = gridDim.x, c = blockIdx.x;
#define IN(k) (ph_lo <= (k) && (k) < ph_hi)
    volatile LAS unsigned* xst = (volatile LAS unsigned*)(lds + LDS_BYTES - 16);
    if (threadIdx.x < 4) xst[threadIdx.x] = 0u;
    __syncthreads();
    const XcdBarrier xbar = xcd_barrier_post((unsigned*)(ws + OFF_BAR), xst);
    if (ph_lo < 0) grid.sync();
#define SEAM(k) do { if (IN(k) && IN((k) + 1)) xcd_barrier(xbar); } while (0)
    if (IN(0)) phase0(p, lds);
    SEAM(0);
    if (IN(1)) {
        pg8::Gemm g{(const bf16_t*)(ws + OFF_XB), (const bf16_t*)(ws + OFF_XB), (const bf16_t*)(ws + OFF_WIN), DM, 1 << 30};
        pg8::StaticOrder S; S.init(MTOK, 8192, G, c, WGM_INPROJ);
        pg8::EpiProj E{ws, p.out, (const float*)(ws + OFF_OML)};
        pg8::gemm_phase(lds, g, S, E);
    }
    SEAM(1);
    if (IN(2)) phase_rec(p, lds);
    SEAM(2);
    if (IN(3)) phase_comb(p);
    SEAM(3);
    if (IN(4)) {
        pg8::Gemm g{(const bf16_t*)(ws + OFF_S1), (const bf16_t*)(ws + OFF_XB), (const bf16_t*)(ws + OFF_WAB), DM, 4};
        pg8::PairOrder S; S.so.init(MTOK, DM, G, c, WGM_NARROW);
        pg8::EpiMerge E{(const bf16_t*)p.out, (bf16_t*)(ws + OFF_S0)};
        pg8::gemm_phase(lds, g, S, E);
    }
    SEAM(4);
    if (IN(5)) {
        pg8::Gemm g{(const bf16_t*)(ws + OFF_S0), (const bf16_t*)(ws + OFF_S0), (const bf16_t*)(ws + OFF_WO), DM, 1 << 30};
        pg8::StaticOrder S; S.init(MTOK, DM, G, c, WGM_NARROW);
        pg8::EpiResid<true, false, false> E{p.x, nullptr, (bf16_t*)(ws + OFF_S4), (float*)(ws + OFF_SSQ2)};
        pg8::gemm_phase(lds, g, S, E);
    }
    SEAM(5);
    if (IN(6)) {
        pg8::Gemm g{(const bf16_t*)(ws + OFF_S4), (const bf16_t*)(ws + OFF_S4), (const bf16_t*)(ws + OFF_WFI), DM, 1 << 30};
        pg8::StaticOrder S; S.init(MTOK, 2 * FF, G, c, WGM_WIDE);
        pg8::EpiSwiglu E{(const float*)(ws + OFF_SSQ2), (bf16_t*)(ws + OFF_ACT)};
        pg8::gemm_phase(lds, g, S, E);
    }
    SEAM(6);
    if (IN(7)) {
        pg8::Gemm g{(const bf16_t*)(ws + OFF_ACT), (const bf16_t*)(ws + OFF_ACT), (const bf16_t*)(ws + OFF_WFO), FF, 1 << 30};
        pg8::StaticOrder S; S.init(MTOK, DM, G, c, WGM_NARROW);
        pg8::EpiResid<true, false, true> E{(const bf16_t*)(ws + OFF_S4), nullptr, (bf16_t*)(ws + OFF_S2), (float*)(ws + OFF_SSQ3)};
        pg8::gemm_phase(lds, g, S, E);
    }
    SEAM(7);
    if (IN(8)) phase_final(p);
    if (IN(9)) phase_digest(p);
#undef IN
#undef SEAM
}

#ifndef N_LAUNCHES
#define N_LAUNCHES 1
#endif

extern "C" void kernel_launch(void* const* d_in, const int* in_sizes, int n_in, void* d_out, int out_size, void* d_ws, size_t ws_size, hipStream_t stream) {
    static int grid = 0;
    if (grid == 0) {
        if (n_in != 14 || in_sizes[0] != MTOK * DM || out_size != MTOK * DM || ws_size < WS_END) {
            fprintf(stderr, "kernel_launch: unexpected shapes (n_in %d, in0 %d, out %d, ws %zu, need %zu)\n", n_in, n_in > 0 ? in_sizes[0] : -1, out_size, ws_size, (size_t)WS_END); grid = -1; return; }
        int dev = 0, cus = 0, per_cu = 0;
        hipGetDevice(&dev);
        hipDeviceGetAttribute(&cus, hipDeviceAttributeMultiprocessorCount, dev);
        if (hipFuncSetAttribute((const void*)fwd_kernel, hipFuncAttributeMaxDynamicSharedMemorySize, LDS_BYTES) != hipSuccess) { fprintf(stderr, "kernel_launch: hipFuncSetAttribute failed\n"); grid = -1; return; }
        if (hipOccupancyMaxActiveBlocksPerMultiprocessor(&per_cu, (const void*)fwd_kernel, 512, LDS_BYTES) != hipSuccess || per_cu < 1) { fprintf(stderr, "kernel_launch: occupancy query failed (%d)\n", per_cu); (void)hipGetLastError(); per_cu = 1; }
        grid = cus * 1;
        if (grid > 256) grid = 256;
    }
    if (grid < 0) return;
    Params p{};
    p.x = (const float*)d_in[0]; p.g_mix = (const float*)d_in[1]; p.w_in = (const float*)d_in[2]; p.lb_logits = (const float*)d_in[3];
    p.hgrn_g = (const float*)d_in[4]; p.pool_w = (const float*)d_in[5]; p.pool_scale = (const float*)d_in[6]; p.w_a = (const float*)d_in[7];
    p.w_b = (const float*)d_in[8]; p.w_out = (const float*)d_in[9]; p.g_ffn = (const float*)d_in[10]; p.w_fi = (const float*)d_in[11];
    p.w_fo = (const float*)d_in[12]; p.g_final = (const float*)d_in[13];
    p.out = (float*)d_out; p.ws = (unsigned char*)d_ws;
    if (hipMemsetAsync((unsigned char*)d_ws + OFF_BAR, 0, XCD_BAR_WORDS * 4, stream) != hipSuccess) { fprintf(stderr, "kernel_launch: memset of the barrier words failed\n"); return; }
#if N_LAUNCHES == 1
    int lo = 0, hi = 9;
    void* args[] = {&p, &lo, &hi};
    hipError_t e = hipLaunchCooperativeKernel((const void*)fwd_kernel, dim3(grid), dim3(512), args, LDS_BYTES, stream);
    if (e != hipSuccess) fprintf(stderr, "kernel_launch: cooperative launch failed: %s (grid %d)\n", hipGetErrorString(e), grid);
#else
    for (int ph = 0; ph < (DBG_STOP >= 0 ? DBG_STOP + 2 : 9); ++ph) {
        int lo = ph, hi = ph + 1;
        if (DBG_STOP >= 0 && ph == DBG_STOP + 1) { lo = 9; hi = 10; }
        void* args[] = {&p, &lo, &hi};
        hipError_t e = hipLaunchCooperativeKernel((const void*)fwd_kernel, dim3(grid), dim3(512), args, LDS_BYTES, stream);
        if (e != hipSuccess) fprintf(stderr, "kernel_launch: launch %d failed: %s (grid %d)\n", ph, hipGetErrorString(e), grid);
    }
#endif
}
```
